# Optimizing an MI355X kernel written in HIP

```python
import math
import jax, jax.numpy as jnp
from jax import lax
import numpy as np

D_MODEL = 2048
BATCH = 4
SEQ = 8192
DEPTH = 1

MLA_HEADS = 8
MLA_NOPE = 128
MLA_ROPE = 64
MLA_QK = MLA_NOPE + MLA_ROPE
MLA_V = 128
MLA_Q_RANK = 768
MLA_KV_RANK = 512
MLA_WIDTH = MLA_HEADS * MLA_V
ROPE_THETA = 10000.0
Q_BLOCK = 128
MOBA_HEADS = 8
MOBA_HEAD_DIM = 128
MOBA_WIDTH = MOBA_HEADS * MOBA_HEAD_DIM
MOBA_BLOCK = 256
MOBA_TOPK = 3
MOBA_Q_CHUNK = 16
MIX_WIDTH = MLA_WIDTH + MOBA_WIDTH
IN_SPLITS = [MLA_Q_RANK, MLA_KV_RANK, MLA_ROPE, MOBA_WIDTH, MOBA_WIDTH, MOBA_WIDTH]
IN_COLS = sum(IN_SPLITS)
PEER_HEADS = 8
PEER_NKEYS = 128
PEER_EXPERTS = PEER_NKEYS * PEER_NKEYS
PEER_DKEY = 256
PEER_TOPK = 16
PEER_TOKEN_CHUNK = 128
EPS = 1e-6
NEG = -1e30

kernel_name = 'hymba_mla_moba_peer_layer'


def rmsnorm(x, g):
    xf = x.astype(jnp.float32)
    y = xf * lax.rsqrt(jnp.mean(xf * xf, axis=-1, keepdims=True) + EPS)
    return (y * g.astype(jnp.float32)).astype(x.dtype)


def rope_tables(seq):
    half = MLA_ROPE // 2
    inv_freq = ROPE_THETA ** (-jnp.arange(half, dtype=jnp.float32) / half)
    ang = jnp.arange(seq, dtype=jnp.float32)[:, None] * inv_freq[None, :]
    return jnp.cos(ang), jnp.sin(ang)


def apply_rope(x, cos, sin):
    half = x.shape[-1] // 2
    x1 = x[..., :half].astype(jnp.float32)
    x2 = x[..., half:].astype(jnp.float32)
    return jnp.concatenate([x1 * cos - x2 * sin, x2 * cos + x1 * sin], axis=-1).astype(x.dtype)


def causal_block_attention(q, k, v, scale):
    B, H, S, Dk = q.shape
    Dv = v.shape[-1]
    nblk = S // Q_BLOCK
    qb = q.reshape(B, H, nblk, Q_BLOCK, Dk).transpose(2, 0, 1, 3, 4)
    kpos = jnp.arange(S)

    def one(args):
        qi, i = args
        s = jnp.einsum('bhqd,bhkd->bhqk', qi, k).astype(jnp.float32) * scale
        qpos = i * Q_BLOCK + jnp.arange(Q_BLOCK)
        s = jnp.where(kpos[None, :] <= qpos[:, None], s, NEG)
        p = jax.nn.softmax(s, axis=-1)
        return jnp.einsum('bhqk,bhkd->bhqd', p.astype(v.dtype), v)

    out = lax.map(one, (qb, jnp.arange(nblk)))
    return out.transpose(1, 2, 0, 3, 4).reshape(B, H, S, Dv)


def mla_group(q_lat, kv_lat, k_rope, g_q, w_uq, g_kv, w_ukv):
    B, S, _ = q_lat.shape
    cos, sin = rope_tables(S)
    q = (rmsnorm(q_lat, g_q) @ w_uq).reshape(B, S, MLA_HEADS, MLA_QK).transpose(0, 2, 1, 3)
    q = jnp.concatenate([q[..., :MLA_NOPE], apply_rope(q[..., MLA_NOPE:], cos, sin)], axis=-1)
    kv = (rmsnorm(kv_lat, g_kv) @ w_ukv).reshape(B, S, MLA_HEADS, MLA_NOPE + MLA_V).transpose(0, 2, 1, 3)
    k_r = apply_rope(k_rope, cos, sin)
    k = jnp.concatenate([kv[..., :MLA_NOPE],
                         jnp.broadcast_to(k_r[:, None], (B, MLA_HEADS, S, MLA_ROPE))], axis=-1)
    v = kv[..., MLA_NOPE:]
    o = causal_block_attention(q, k, v, 1.0 / math.sqrt(MLA_QK))
    return o.transpose(0, 2, 1, 3).reshape(B, S, MLA_WIDTH)


def moba_group(q_in, k_in, v_in):
    B, S, _ = q_in.shape
    H, Dh, L, C = MOBA_HEADS, MOBA_HEAD_DIM, MOBA_BLOCK, MOBA_Q_CHUNK
    q = q_in.reshape(B, S, H, Dh).transpose(0, 2, 1, 3)
    k = k_in.reshape(B, S, H, Dh).transpose(0, 2, 1, 3)
    v = v_in.reshape(B, S, H, Dh).transpose(0, 2, 1, 3)
    scale = 1.0 / math.sqrt(Dh)
    slopes = 2.0 ** (-8.0 * (jnp.arange(H, dtype=jnp.float32) + 1.0) / H)
    nb = -(-S // L)
    pad = nb * L - S
    kp = jnp.pad(k, ((0, 0), (0, 0), (0, pad), (0, 0)))
    vp = jnp.pad(v, ((0, 0), (0, 0), (0, pad), (0, 0)))
    kb = kp.reshape(B, H, nb, L, Dh)
    vb = vp.reshape(B, H, nb, L, Dh)
    kmean = jnp.mean(kb.astype(jnp.float32), axis=3)
    pos = jnp.arange(S)
    qblk = pos // L
    gate = jnp.einsum('bhsd,bhnd->bhsn', q.astype(jnp.float32), kmean)
    gate = jnp.where(jnp.arange(nb)[None, :] < qblk[:, None], gate, NEG)
    k_sel = min(MOBA_TOPK, nb)
    _, sel = lax.top_k(gate, k_sel)
    valid = jnp.arange(k_sel)[None, :] < qblk[:, None]
    nc = S // C
    qc = q.reshape(B, H, nc, C, Dh).transpose(2, 0, 1, 3, 4)
    selc = sel.reshape(B, H, nc, C, k_sel).transpose(2, 0, 1, 3, 4)
    validc = valid.reshape(nc, C, k_sel)
    bi = jnp.arange(B)[:, None, None, None]
    hi = jnp.arange(H)[None, :, None, None]
    offs = jnp.arange(L)

    def one(args):
        qi, si, vi, ci = args
        qpos = ci * C + jnp.arange(C)
        own = (ci * C) // L
        kg = kb[bi, hi, si]
        vg = vb[bi, hi, si]
        s_past = jnp.einsum('bhcd,bhcnld->bhcnl', qi, kg).astype(jnp.float32) * scale
        kpos_past = si[..., None] * L + offs
        s_past = s_past - slopes[None, :, None, None, None] * (qpos[None, None, :, None, None] - kpos_past)
        s_past = jnp.where(vi[None, None, :, :, None], s_past, NEG).reshape(B, H, C, k_sel * L)
        ko = lax.dynamic_slice_in_dim(kp, own * L, L, axis=2)
        vo = lax.dynamic_slice_in_dim(vp, own * L, L, axis=2)
        kpos_own = own * L + offs
        s_own = jnp.einsum('bhcd,bhld->bhcl', qi, ko).astype(jnp.float32) * scale
        s_own = s_own - slopes[None, :, None, None] * (qpos[:, None] - kpos_own[None, :])
        s_own = jnp.where(kpos_own[None, :] <= qpos[:, None], s_own, NEG)
        p = jax.nn.softmax(jnp.concatenate([s_past, s_own], axis=-1), axis=-1).astype(v.dtype)
        p_past = p[..., :k_sel * L].reshape(B, H, C, k_sel, L)
        p_own = p[..., k_sel * L:]
        return (jnp.einsum('bhcnl,bhcnld->bhcd', p_past, vg)
                + jnp.einsum('bhcl,bhld->bhcd', p_own, vo))

    out = lax.map(one, (qc, selc, validc, jnp.arange(nc)))
    out = out.transpose(1, 2, 0, 3, 4).reshape(B, H, S, Dh)
    return out.transpose(0, 2, 1, 3).reshape(B, S, MOBA_WIDTH)


def peer(h, w_q, sub_k1, sub_k2, u_tab, v_tab):
    B, S, D = h.shape
    T = B * S
    H, K = PEER_HEADS, PEER_TOPK
    hf = h.reshape(T, D)
    q = (hf @ w_q).reshape(T, H, 2, PEER_DKEY // 2)
    s1 = jnp.einsum('thd,hnd->thn', q[:, :, 0], sub_k1).astype(jnp.float32)
    s2 = jnp.einsum('thd,hnd->thn', q[:, :, 1], sub_k2).astype(jnp.float32)
    v1, i1 = lax.top_k(s1, K)
    v2, i2 = lax.top_k(s2, K)
    cand = (v1[..., :, None] + v2[..., None, :]).reshape(T, H, K * K)
    cand_id = (i1[..., :, None] * PEER_NKEYS + i2[..., None, :]).reshape(T, H, K * K)
    top, slot = lax.top_k(cand, K)
    ids = jnp.take_along_axis(cand_id, slot, axis=-1).reshape(T, H * K)
    g = jax.nn.softmax(top, axis=-1).reshape(T, H * K).astype(h.dtype)
    nchunk = T // PEER_TOKEN_CHUNK

    def one(args):
        hc, ic, gc = args
        a = jax.nn.gelu(jnp.einsum('cd,ckd->ck', hc, u_tab[ic]), approximate=False) * gc
        return jnp.einsum('ck,ckd->cd', a, v_tab[ic])

    out = lax.map(one, (hf.reshape(nchunk, PEER_TOKEN_CHUNK, D),
                        ids.reshape(nchunk, PEER_TOKEN_CHUNK, H * K),
                        g.reshape(nchunk, PEER_TOKEN_CHUNK, H * K)))
    return out.reshape(B, S, D)


def setup_inputs(seed: int = 0) -> dict:
    key = jax.random.key(seed)
    ks = jax.random.split(key, 22)
    L = DEPTH

    def nrm(k, shape, scale):
        return jax.random.normal(k, shape, jnp.float32) * scale

    def gain(k, shape):
        return 1.0 + 0.02 * jax.random.normal(k, shape, jnp.float32)

    return {
        'x': nrm(ks[0], (BATCH, SEQ, D_MODEL), 1.0),
        'c': nrm(ks[1], (BATCH, D_MODEL), 1.0),
        'w_ada': nrm(ks[2], (L, D_MODEL, 6 * D_MODEL), 0.5 * D_MODEL ** -0.5),
        'b_ada': nrm(ks[3], (L, 6 * D_MODEL), 0.01),
        'g_pre_mix': gain(ks[4], (L, D_MODEL)),
        'w_in': nrm(ks[5], (L, D_MODEL, IN_COLS), D_MODEL ** -0.5),
        'g_q_lat': gain(ks[6], (L, MLA_Q_RANK)),
        'w_uq': nrm(ks[7], (L, MLA_Q_RANK, MLA_HEADS * MLA_QK), MLA_Q_RANK ** -0.5),
        'g_kv_lat': gain(ks[8], (L, MLA_KV_RANK)),
        'w_ukv': nrm(ks[9], (L, MLA_KV_RANK, MLA_HEADS * (MLA_NOPE + MLA_V)), MLA_KV_RANK ** -0.5),
        'g_out_mla': gain(ks[10], (L, MLA_WIDTH)),
        'g_out_moba': gain(ks[11], (L, MOBA_WIDTH)),
        'w_out': nrm(ks[12], (L, MIX_WIDTH, D_MODEL), MIX_WIDTH ** -0.5),
        'g_post_mix': gain(ks[13], (L, D_MODEL)),
        'g_pre_ffn': gain(ks[14], (L, D_MODEL)),
        'w_peer_q': nrm(ks[15], (L, D_MODEL, PEER_HEADS * PEER_DKEY), D_MODEL ** -0.5),
        'sub_keys_1': nrm(ks[16], (L, PEER_HEADS, PEER_NKEYS, PEER_DKEY // 2), (PEER_DKEY // 2) ** -0.5),
        'sub_keys_2': nrm(ks[17], (L, PEER_HEADS, PEER_NKEYS, PEER_DKEY // 2), (PEER_DKEY // 2) ** -0.5),
        'u_experts': nrm(ks[18], (L, PEER_EXPERTS, D_MODEL), D_MODEL ** -0.5),
        'v_experts': nrm(ks[19], (L, PEER_EXPERTS, D_MODEL), (PEER_HEADS * PEER_TOPK) ** -0.5),
        'g_post_ffn': gain(ks[20], (L, D_MODEL)),
    }


def reference(x, c, w_ada, b_ada, g_pre_mix, w_in, g_q_lat, w_uq, g_kv_lat, w_ukv,
              g_out_mla, g_out_moba, w_out, g_post_mix, g_pre_ffn, w_peer_q,
              sub_keys_1, sub_keys_2, u_experts, v_experts, g_post_ffn):
    B = x.shape[0]
    cs = jax.nn.silu(c)
    offsets = list(np.cumsum(IN_SPLITS)[:-1])
    for l in range(DEPTH):
        mod = (cs @ w_ada[l] + b_ada[l]).reshape(B, 6, 1, D_MODEL)
        shift1, scale1, gate1 = mod[:, 0], mod[:, 1], mod[:, 2]
        shift2, scale2, gate2 = mod[:, 3], mod[:, 4], mod[:, 5]
        h = rmsnorm(x, g_pre_mix[l]) * (1.0 + scale1) + shift1
        proj = h @ w_in[l]
        q_lat, kv_lat, k_rope, mq, mk, mv = jnp.split(proj, offsets, axis=-1)
        o_mla = mla_group(q_lat, kv_lat, k_rope, g_q_lat[l], w_uq[l], g_kv_lat[l], w_ukv[l])
        o_moba = moba_group(mq, mk, mv)
        o = jnp.concatenate([rmsnorm(o_mla, g_out_mla[l]), rmsnorm(o_moba, g_out_moba[l])], axis=-1)
        x = x + gate1 * rmsnorm(o @ w_out[l], g_post_mix[l])
        h2 = rmsnorm(x, g_pre_ffn[l]) * (1.0 + scale2) + shift2
        y2 = peer(h2, w_peer_q[l], sub_keys_1[l], sub_keys_2[l], u_experts[l], v_experts[l])
        x = x + gate2 * rmsnorm(y2, g_post_ffn[l])
    return x
```

```cpp
#include <hip/hip_runtime.h>
#include <cstdio>
#include <cstdint>
#include <cmath>
#include <type_traits>

#ifndef MK_N_LAUNCHES
#define MK_N_LAUNCHES 1
#endif

#define LAS __attribute__((address_space(3)))
#define GAS __attribute__((address_space(1)))
typedef unsigned short bf16_t;
typedef short bf16x8 __attribute__((ext_vector_type(8)));
typedef float f32x4 __attribute__((ext_vector_type(4)));
typedef float f32x2 __attribute__((ext_vector_type(2)));
typedef float f32x16 __attribute__((ext_vector_type(16)));
typedef unsigned u32x4 __attribute__((ext_vector_type(4)));
typedef unsigned u32x2 __attribute__((ext_vector_type(2)));
typedef __bf16 bf2_t __attribute__((ext_vector_type(2)));

constexpr int NB = 4, SEQ = 8192, DM = 2048, NT = NB * SEQ;
constexpr int QR = 768, KVR = 512, ROPE = 64, NOPE = 128, QKD = 192, VD = 128, NH = 8;
constexpr int MW = 1024;
constexpr int NEXP = 16384, PK = 16, NKEY = 128;
constexpr float EPS = 1e-6f;

__device__ __forceinline__ unsigned cvt_pk_bf16(float lo, float hi) { unsigned r; asm volatile("v_cvt_pk_bf16_f32 %0, %1, %2" : "=v"(r) : "v"(lo), "v"(hi)); return r; }
__device__ __forceinline__ float bf_lo(unsigned w) { return __uint_as_float(w << 16); }
__device__ __forceinline__ float bf_hi(unsigned w) { return __uint_as_float(w & 0xffff0000u); }
template <int CTRL> __device__ __forceinline__ float dpp_f(float x) { return __uint_as_float(__builtin_amdgcn_update_dpp(0u, __float_as_uint(x), CTRL, 0xf, 0xf, false)); }
template <int CTRL> __device__ __forceinline__ int dpp_i(int x) { return (int)__builtin_amdgcn_update_dpp(0u, (unsigned)x, CTRL, 0xf, 0xf, false); }
#define DPP_XOR1 0xB1
#define DPP_XOR2 0x4E
#define DPP_HMIRROR 0x141
#define DPP_XOR8 0x128
__device__ __forceinline__ float sum_x16(float x) { auto r = __builtin_amdgcn_permlane16_swap(__float_as_uint(x), __float_as_uint(x), false, false); return __uint_as_float(r[0]) + __uint_as_float(r[1]); }
__device__ __forceinline__ float sum_x32(float x) { auto r = __builtin_amdgcn_permlane32_swap(__float_as_uint(x), __float_as_uint(x), false, false); return __uint_as_float(r[0]) + __uint_as_float(r[1]); }
__device__ __forceinline__ float wave_sum(float v) {
#pragma unroll
    for (int o = 1; o < 64; o <<= 1) v += __shfl_xor(v, o);
    return v;
}

namespace pg8 {
constexpr int BM = 256, BK = 64, HALF = 128, HTB = HALF * BK * 2  , STAGE_BYTES = 8 * HTB, NXCD = 8, WGM = 8;

__host__ __device__ __forceinline__ int lds_byte(int r, int c) { const int st = (r >> 4) * 2 + (c >> 5), rr = r & 15, cc = c & 31, ob = rr * 64 + cc * 2; return st * 1024 + (ob ^ (((ob >> 9) & 1) << 5)); }
__host__ __device__ __forceinline__ void stage_rc(int b, int& R, int& C) { const int st = b / 1024, sb = b % 1024, swz = sb ^ (((sb >> 9) & 1) << 5); R = (st >> 1) * 16 + swz / 64; C = (st & 1) * 32 + (swz % 64) / 2; }
__host__ __device__ __forceinline__ int perm32(int rho) { const int n = rho >> 4, i = rho & 15; return 8 * (i >> 2) + 4 * n + (i & 3); }

struct Unit { int pm, pn; };
struct Gemm { const bf16_t* A; const bf16_t* Bt; int lda, ldb, K, bko; };

struct StaticOrder {
    int nM, nN, nwg, G, c;
    __host__ __device__ void init(int M, int N, int G_, int c_) { nM = M / BM; nN = N / BM; nwg = nM * nN; G = G_; c = c_; }
    __host__ __device__ bool next(int i, Unit& u) const {
        const long L = (long)i * G + c; if (L >= nwg) return false;
        int wgid = (int)L; { const int q = nwg / NXCD, r = nwg % NXCD, xcd = wgid % NXCD, off = wgid / NXCD; wgid = (xcd < r ? xcd * (q + 1) : r * (q + 1) + (xcd - r) * q) + off; }
        const int nig = WGM * nN, gid = wgid / nig, fm = gid * WGM, gsz = (nM - fm) < WGM ? (nM - fm) : WGM;
        u.pm = fm + ((wgid % nig) % gsz); u.pn = (wgid % nig) / gsz; return true;
    }
};

template <class Epi, class Sched>
__device__ __forceinline__ void gemm_phase(LAS unsigned char* lds, const Gemm g, const Sched& S, const Epi& E) {
    int tid = threadIdx.x; asm volatile("" : "+v"(tid));
    const int wid = __builtin_amdgcn_readfirstlane(tid >> 6), lane = tid & 63, wr = wid >> 2, wc = wid & 3, fr = lane & 15, fq = lane >> 4;
    const int K = g.K, nt = K / BK;
    unsigned voffA[2], voffB[2];
#pragma unroll
    for (int i = 0; i < 2; ++i) { int R, C; stage_rc(tid * 16 + i * 8192, R, C); const int Rb = (R & ~31) + perm32(R & 31);
        voffA[i] = (unsigned)(R * g.lda + C) * 2u; voffB[i] = (unsigned)(Rb * g.ldb + C) * 2u; }
    const size_t kstep = (size_t)(BK * 2);
    const size_t hstepA = (size_t)HALF * g.lda * 2, hstepB = (size_t)HALF * g.ldb * 2;
    const size_t tstepA = 2 * hstepA, tstepB = 2 * hstepB;
    const unsigned ldsw = (unsigned)wid * 1024u;
    const int aoff = lds_byte(wr * 64 + fr, fq * 8), boff = lds_byte(wc * 32 + fr, fq * 8);
#define PG8_SA(b, h) (((b) * 2 + (h)) * HTB)
#define PG8_SB(b, h) ((4 + (b) * 2 + (h)) * HTB)
#define PG8_STAGE(bufoff, gbase, voff) do { _Pragma("unroll") for (int _i = 0; _i < 2; ++_i) \
        __builtin_amdgcn_global_load_lds((const unsigned*)((const char*)(gbase) + (voff)[_i]), (LAS unsigned*)(lds + (bufoff) + ldsw + _i * 8192), 16, 0, 0); } while (0)
#define PG8_LDA(dst, b, h) do { _Pragma("unroll") for (int m = 0; m < 4; ++m) _Pragma("unroll") for (int k = 0; k < 2; ++k) dst[m][k] = *(const LAS bf16x8*)(lds + PG8_SA(b, h) + aoff + m * 2048 + k * 1024); } while (0)
#define PG8_LDB(dst, b, h) do { _Pragma("unroll") for (int n = 0; n < 2; ++n) _Pragma("unroll") for (int k = 0; k < 2; ++k) dst[n][k] = *(const LAS bf16x8*)(lds + PG8_SB(b, h) + boff + n * 2048 + k * 1024); } while (0)
#define PG8_MMA(ai, bj, At, Bt) do { __builtin_amdgcn_s_setprio(1); _Pragma("unroll") for (int m = 0; m < 4; ++m) _Pragma("unroll") for (int n = 0; n < 2; ++n) _Pragma("unroll") for (int k = 0; k < 2; ++k) \
        acc[ai][bj][m][n] = __builtin_amdgcn_mfma_f32_16x16x32_bf16(Bt[n][k], At[m][k], acc[ai][bj][m][n], 0, 0, 0); __builtin_amdgcn_s_setprio(0); } while (0)
#define PG8_WAIT_V(n) asm volatile("s_waitcnt vmcnt(" #n ")" ::: "memory")
#define PG8_WAIT_L(n) asm volatile("s_waitcnt lgkmcnt(" #n ")" ::: "memory")
#define PG8_BAR __builtin_amdgcn_s_barrier()
#define PG8_SCHED __builtin_amdgcn_sched_barrier(0)
    Unit cur, nxt; int ui = 0;
    if (!S.next(0, cur)) return;
    f32x4 acc[2][2][4][2];
#pragma unroll
    for (int a = 0; a < 2; ++a)
#pragma unroll
        for (int b = 0; b < 2; ++b)
#pragma unroll
            for (int m = 0; m < 4; ++m)
#pragma unroll
                for (int n = 0; n < 2; ++n) acc[a][b][m][n] = (f32x4){0.f, 0.f, 0.f, 0.f};
    bf16x8 At[4][2], B0[2][2], B1[2][2];
    const char* cA = (const char*)g.A + (size_t)cur.pm * tstepA; const char* cB = (const char*)g.Bt + (size_t)cur.pn * tstepB + (size_t)cur.pm * g.bko * 2;
    PG8_STAGE(PG8_SB(0, 0), cB, voffB); PG8_STAGE(PG8_SB(0, 1), cB + hstepB, voffB); PG8_STAGE(PG8_SA(0, 0), cA, voffA); PG8_STAGE(PG8_SA(0, 1), cA + hstepA, voffA);
    if (wr == 1) PG8_BAR;
    PG8_WAIT_V(2); PG8_BAR;
    PG8_STAGE(PG8_SB(1, 0), cB + kstep, voffB); PG8_STAGE(PG8_SA(1, 0), cA + kstep, voffA); PG8_STAGE(PG8_SB(1, 1), cB + hstepB + kstep, voffB);
    PG8_WAIT_V(6); PG8_BAR;
    for (;;) {
        const bool has_next = S.next(ui + 1, nxt);
        const char* nA = has_next ? (const char*)g.A + (size_t)nxt.pm * tstepA : cA;
        const char* nB = has_next ? (const char*)g.Bt + (size_t)nxt.pn * tstepB + (size_t)nxt.pm * g.bko * 2 : cB;
        for (int t = 0; t < nt; t += 2) {
            const bool last = (t == nt - 2);
            if constexpr (Epi::HAS_MID) { if (2 * t == nt) E.mid(acc, cur, wr, wc, fr, fq); }
            const char* a1 = cA + (size_t)(t + 1) * kstep;
            const char* a2 = last ? nA : cA + (size_t)(t + 2) * kstep; const char* b2 = last ? nB : cB + (size_t)(t + 2) * kstep;
            const char* a3 = a2 + kstep; const char* b3 = b2 + kstep;
            PG8_LDB(B0, 0, 0); PG8_LDB(B1, 0, 1); PG8_SCHED; PG8_LDA(At, 0, 0); PG8_STAGE(PG8_SA(1, 1), a1 + hstepA, voffA);
            PG8_WAIT_V(8); PG8_WAIT_L(0); PG8_BAR; PG8_MMA(0, 0, At, B0); PG8_MMA(0, 1, At, B1); PG8_BAR; PG8_SCHED;
            PG8_LDA(At, 0, 1); PG8_STAGE(PG8_SB(0, 0), b2, voffB); PG8_STAGE(PG8_SB(0, 1), b2 + hstepB, voffB); PG8_STAGE(PG8_SA(0, 0), a2, voffA);
            PG8_WAIT_V(8); PG8_WAIT_L(0); PG8_BAR; PG8_MMA(1, 0, At, B0); PG8_MMA(1, 1, At, B1); PG8_BAR; PG8_SCHED;
            PG8_LDB(B0, 1, 0); PG8_LDB(B1, 1, 1); PG8_SCHED; PG8_LDA(At, 1, 0); PG8_STAGE(PG8_SA(0, 1), a2 + hstepA, voffA);
            PG8_WAIT_V(8); PG8_WAIT_L(0); PG8_BAR; PG8_MMA(0, 0, At, B0); PG8_MMA(0, 1, At, B1); PG8_BAR; PG8_SCHED;
            PG8_LDA(At, 1, 1); PG8_STAGE(PG8_SB(1, 0), b3, voffB); PG8_STAGE(PG8_SB(1, 1), b3 + hstepB, voffB); PG8_STAGE(PG8_SA(1, 0), a3, voffA);
            PG8_WAIT_V(8); PG8_WAIT_L(0); PG8_BAR; PG8_MMA(1, 0, At, B0); PG8_MMA(1, 1, At, B1); PG8_BAR; PG8_SCHED;
        }
        if (wr == 0) PG8_BAR;
        E(acc, cur, wr, wc, fr, fq);
        if (!has_next) break;
#pragma unroll
        for (int a = 0; a < 2; ++a)
#pragma unroll
            for (int b = 0; b < 2; ++b)
#pragma unroll
                for (int m = 0; m < 4; ++m)
#pragma unroll
                    for (int n = 0; n < 2; ++n) acc[a][b][m][n] = (f32x4){0.f, 0.f, 0.f, 0.f};
        cur = nxt; cA = nA; cB = nB; ++ui;
        if (wr == 1) PG8_BAR;
    }
    PG8_WAIT_V(0);
    PG8_BAR;
#undef PG8_SA
#undef PG8_SB
#undef PG8_STAGE
#undef PG8_LDA
#undef PG8_LDB
#undef PG8_MMA
#undef PG8_WAIT_V
#undef PG8_WAIT_L
#undef PG8_BAR
#undef PG8_SCHED
}
}
namespace epi {
using pg8::Unit;
typedef f32x4 Acc[2][2][4][2];
__device__ __forceinline__ void st8(bf16_t* p, f32x4 v0, f32x4 v1) { u32x4 w; w.x = cvt_pk_bf16(v0[0], v0[1]); w.y = cvt_pk_bf16(v0[2], v0[3]); w.z = cvt_pk_bf16(v1[0], v1[1]); w.w = cvt_pk_bf16(v1[2], v1[3]); *(u32x4*)p = w; }
__device__ __forceinline__ float sq8(f32x4 a, f32x4 b) { return (a[0] * a[0] + a[1] * a[1]) + (a[2] * a[2] + a[3] * a[3]) + (b[0] * b[0] + b[1] * b[1]) + (b[2] * b[2] + b[3] * b[3]); }
typedef unsigned long long fx_t;
__device__ __forceinline__ void atomic_add_fx(fx_t* p, float v) { const long long q = __float2ll_rn(v * 1048576.0f); __hip_atomic_fetch_add(p, (fx_t)q, __ATOMIC_RELAXED, __HIP_MEMORY_SCOPE_AGENT); }
__device__ __forceinline__ float fx2f(fx_t v) { return (float)((double)(long long)v * (1.0 / 1048576.0)); }
__device__ __forceinline__ void rope8(f32x4& v0, f32x4& v1, const f32x2* rope, int pos, int i0) {
    const f32x2* t = rope + (size_t)pos * 32 + i0;
    const f32x2 a = t[0], b = t[1], c = t[2], d = t[3];
    f32x4 o0, o1;
    o0[0] = v0[0] * a.x - v0[1] * a.y; o0[1] = v0[1] * a.x + v0[0] * a.y;
    o0[2] = v0[2] * b.x - v0[3] * b.y; o0[3] = v0[3] * b.x + v0[2] * b.y;
    o1[0] = v1[0] * c.x - v1[1] * c.y; o1[1] = v1[1] * c.x + v1[0] * c.y;
    o1[2] = v1[2] * d.x - v1[3] * d.y; o1[3] = v1[3] * d.x + v1[2] * d.y;
    v0 = o0; v1 = o1;
}

struct EpiProj {
    static constexpr bool HAS_MID = false;
    bf16_t *QLAT, *KVLAT, *KR, *MQ, *MK; fx_t *ssq, *sskv; const f32x2* rope;
    __device__ __forceinline__ void operator()(const Acc& acc, const Unit& u, int wr, int wc, int fr, int fq) const {
        const int pn = u.pn, row0 = u.pm * 256 + wr * 64 + fr;
        if (pn == 5) {
            if (wc >= 2) return;
            const int col0 = wc * 32 + 8 * fq;
#pragma unroll
            for (int ai = 0; ai < 2; ++ai)
#pragma unroll
                for (int m = 0; m < 4; ++m) { const int row = row0 + ai * 128 + m * 16; f32x4 v0 = acc[ai][0][m][0], v1 = acc[ai][0][m][1];
                    rope8(v0, v1, rope, row & (SEQ - 1), col0 >> 1); st8(KR + (size_t)row * 64 + col0, v0, v1); }
            return;
        }
        bf16_t* dst; int ld, cb; fx_t* ss = nullptr;
        if (pn < 3) { dst = QLAT; ld = QR; cb = pn * 256; ss = ssq; }
        else if (pn < 5) { dst = KVLAT; ld = KVR; cb = (pn - 3) * 256; ss = sskv; }
        else if (pn < 10) { dst = MQ; ld = MW; cb = (pn - 6) * 256; }
        else { dst = MK; ld = MW; cb = (pn - 10) * 256; }
        const int col0 = cb + wc * 32 + 8 * fq;
#pragma unroll
        for (int ai = 0; ai < 2; ++ai)
#pragma unroll
            for (int m = 0; m < 4; ++m) { const int row = row0 + ai * 128 + m * 16; float s = 0.f;
#pragma unroll
                for (int bj = 0; bj < 2; ++bj) { const f32x4 v0 = acc[ai][bj][m][0], v1 = acc[ai][bj][m][1]; s += sq8(v0, v1); st8(dst + (size_t)row * ld + col0 + bj * 128, v0, v1); }
                if (ss) { s += __shfl_xor(s, 16); s += __shfl_xor(s, 32); if (fq == 0) atomic_add_fx(ss + row, s); } }
    }
};
struct EpiVT {
    static constexpr bool HAS_MID = false;
    bf16_t* VT; const fx_t* ss; float inv_n;
    __device__ __forceinline__ void operator()(const Acc& acc, const Unit& u, int wr, int wc, int fr, int fq) const {
        const int f0 = u.pm * 256 + wr * 64 + fr;
#pragma unroll
        for (int bj = 0; bj < 2; ++bj) { const int tok = u.pn * 256 + bj * 128 + wc * 32 + 8 * fq; const int b = tok / SEQ, s = tok % SEQ;
            f32x4 r0 = {1.f, 1.f, 1.f, 1.f}, r1 = r0;
            if (ss) {
#pragma unroll
                for (int j = 0; j < 4; ++j) { r0[j] = 1.0f / sqrtf(fx2f(ss[tok + j]) * inv_n + EPS); r1[j] = 1.0f / sqrtf(fx2f(ss[tok + 4 + j]) * inv_n + EPS); } }
#pragma unroll
            for (int ai = 0; ai < 2; ++ai)
#pragma unroll
                for (int m = 0; m < 4; ++m) { const int f = f0 + ai * 128 + m * 16;
                    st8(VT + ((size_t)(b * 1024 + f)) * SEQ + s, acc[ai][bj][m][0] * r0, acc[ai][bj][m][1] * r1); } }
    }
};
struct EpiQ {
    static constexpr bool HAS_MID = false;
    bf16_t* Q; const fx_t* ss; const f32x2* rope;
    __device__ __forceinline__ void operator()(const Acc& acc, const Unit& u, int wr, int wc, int fr, int fq) const {
        const int row0 = u.pm * 256 + wr * 64 + fr;
#pragma unroll
        for (int ai = 0; ai < 2; ++ai)
#pragma unroll
            for (int m = 0; m < 4; ++m) { const int row = row0 + ai * 128 + m * 16; const float rs = 1.0f / sqrtf(fx2f(ss[row]) * (1.0f / QR) + EPS);
#pragma unroll
                for (int bj = 0; bj < 2; ++bj) { const int c0 = u.pn * 256 + bj * 128 + wc * 32 + 8 * fq, j0 = c0 % QKD;
                    f32x4 v0 = acc[ai][bj][m][0] * rs, v1 = acc[ai][bj][m][1] * rs;
                    if (j0 >= NOPE) rope8(v0, v1, rope, row & (SEQ - 1), (j0 - NOPE) >> 1);
                    st8(Q + (size_t)row * (NH * QKD) + c0, v0, v1); } }
    }
};
struct EpiRow {
    static constexpr bool HAS_MID = false;
    bf16_t* O; int ld; const fx_t* ss; float inv_n;
    __device__ __forceinline__ void operator()(const Acc& acc, const Unit& u, int wr, int wc, int fr, int fq) const {
        const int row0 = u.pm * 256 + wr * 64 + fr, col0 = u.pn * 256 + wc * 32 + 8 * fq;
#pragma unroll
        for (int ai = 0; ai < 2; ++ai)
#pragma unroll
            for (int m = 0; m < 4; ++m) { const int row = row0 + ai * 128 + m * 16; const float rs = ss ? 1.0f / sqrtf(fx2f(ss[row]) * inv_n + EPS) : 1.0f;
#pragma unroll
                for (int bj = 0; bj < 2; ++bj) st8(O + (size_t)row * ld + col0 + bj * 128, acc[ai][bj][m][0] * rs, acc[ai][bj][m][1] * rs); }
    }
};
struct EpiOut {
    static constexpr bool HAS_MID = true;
    bf16_t* Y; const fx_t *ssa, *ssb; fx_t* ssy;
    __device__ __forceinline__ void mid(Acc& acc, const Unit& u, int wr, int wc, int fr, int fq) const {
        int row0 = u.pm * 256 + wr * 64 + fr; asm volatile("" : "+v"(row0));
#pragma unroll
        for (int ai = 0; ai < 2; ++ai)
#pragma unroll
            for (int m = 0; m < 4; ++m) { const int row = row0 + ai * 128 + m * 16;
                const float ra = 1.0f / sqrtf(fx2f(ssa[row]) * (1.0f / MW) + EPS), rb = 1.0f / sqrtf(fx2f(ssb[row]) * (1.0f / MW) + EPS), f = ra / rb;
#pragma unroll
                for (int bj = 0; bj < 2; ++bj) { acc[ai][bj][m][0] *= f; acc[ai][bj][m][1] *= f; } }
    }
    __device__ __forceinline__ void operator()(const Acc& acc, const Unit& u, int wr, int wc, int fr, int fq) const {
        const int row0 = u.pm * 256 + wr * 64 + fr, col0 = u.pn * 256 + wc * 32 + 8 * fq;
#pragma unroll
        for (int ai = 0; ai < 2; ++ai)
#pragma unroll
            for (int m = 0; m < 4; ++m) { const int row = row0 + ai * 128 + m * 16; const float rb = 1.0f / sqrtf(fx2f(ssb[row]) * (1.0f / MW) + EPS); float s = 0.f;
#pragma unroll
                for (int bj = 0; bj < 2; ++bj) { const f32x4 v0 = acc[ai][bj][m][0] * rb, v1 = acc[ai][bj][m][1] * rb; s += sq8(v0, v1); st8(Y + (size_t)row * DM + col0 + bj * 128, v0, v1); }
                s += __shfl_xor(s, 16); s += __shfl_xor(s, 32); if (fq == 0) atomic_add_fx(ssy + row, s); }
    }
};
typedef _Float16 f16x2 __attribute__((ext_vector_type(2)));
__device__ __forceinline__ unsigned pk_f16(float a, float b) { const f16x2 v = {(_Float16)a, (_Float16)b}; return __builtin_bit_cast(unsigned, v); }
struct EpiSc {
    static constexpr bool HAS_MID = false;
    _Float16* SC;
    __device__ __forceinline__ void operator()(const Acc& acc, const Unit& u, int wr, int wc, int fr, int fq) const {
        const int row0 = u.pm * 256 + wr * 64 + fr, col0 = u.pn * 256 + wc * 32 + 8 * fq;
#pragma unroll
        for (int ai = 0; ai < 2; ++ai)
#pragma unroll
            for (int m = 0; m < 4; ++m) { _Float16* p = SC + (size_t)(row0 + ai * 128 + m * 16) * NT + col0;
#pragma unroll
                for (int bj = 0; bj < 2; ++bj) { const f32x4 v0 = acc[ai][bj][m][0], v1 = acc[ai][bj][m][1];
                    *(u32x4*)(p + bj * 128) = (u32x4){pk_f16(v0[0], v0[1]), pk_f16(v0[2], v0[3]), pk_f16(v1[0], v1[1]), pk_f16(v1[2], v1[3])};
                    __builtin_amdgcn_sched_barrier(0); } }
    }
};
}
namespace attn {
struct Args {
    const bf16_t *Qm, *Km, *KR, *VmT;
    const bf16_t *MQ, *MK, *MVT, *KMEAN;
    const float* KMAX;
    unsigned* SELM;
    unsigned short* LIST; int* CNT;
    float* QN;
    bf16_t* PO; f32x2* PML;
    bf16_t* O;
    epi::fx_t *ssa, *ssb;
};
__device__ __forceinline__ f32x16 mfma32(bf16x8 a, bf16x8 b, f32x16 c) { return __builtin_amdgcn_mfma_f32_32x32x16_bf16(a, b, c, 0, 0, 0); }
__device__ __forceinline__ bf16x8 pack8(const f32x16& p, int b0) {
    u32x4 w; w.x = cvt_pk_bf16(p[b0 + 0], p[b0 + 1]); w.y = cvt_pk_bf16(p[b0 + 2], p[b0 + 3]); w.z = cvt_pk_bf16(p[b0 + 4], p[b0 + 5]); w.w = cvt_pk_bf16(p[b0 + 6], p[b0 + 7]);
    return __builtin_bit_cast(bf16x8, w);
}
__device__ __forceinline__ float xhalf_max(float v) { return fmaxf(v, __shfl_xor(v, 32)); }

template <int DK, int MODE>
__device__ __forceinline__ void attn_block(LAS unsigned char* lds, const Args& A, int b, int h, int qb, int chunk = 0, int cnt = 0) {
    constexpr bool MOBA = MODE != 0;
    constexpr int KST = DK * 2 + 16, VST = 144, KBUF = 64 * KST, VBUF = 128 * VST, SET = KBUF + VBUF, NS = DK / 16;
    static_assert(2 * SET <= 131072, "attention LDS map");
    int tid = threadIdx.x; asm volatile("" : "+v"(tid));
    const int wid = __builtin_amdgcn_readfirstlane(tid >> 6), lane = tid & 63, r32 = lane & 31, hi = lane >> 5;
    const size_t tokb = (size_t)b * SEQ;
    int q0 = qb * 256, qw0 = q0 + wid * 32, qpos = qw0 + r32; bool qvalid = true;
    if constexpr (MODE == 2) {
        const int li = chunk * 256 + wid * 32 + r32; qvalid = li < cnt;
        qpos = A.LIST[(size_t)((b * NH + h) * 32 + qb) * SEQ + (qvalid ? li : 0)]; q0 = 0; qw0 = 1 << 20; }
    const float NEG = -__builtin_inff();
    bf16x8 qr[NS];
    { const bf16_t* qp = MOBA ? A.MQ + (tokb + qpos) * MW + h * 128 + hi * 8 : A.Qm + (tokb + qpos) * (NH * QKD) + h * QKD + hi * 8;
#pragma unroll
      for (int s = 0; s < NS; ++s) qr[s] = *(const bf16x8*)(qp + 16 * s); }
    const bf16_t* baseN = (MOBA ? A.MK : A.Km) + tokb * 1024 + h * 128;
    const bf16_t* baseR = A.KR + tokb * ROPE;
    const bf16_t* baseV = (MOBA ? A.MVT : A.VmT) + ((size_t)(b * 1024 + h * 128)) * SEQ;
    const unsigned offN = (unsigned)((tid >> 4) * 1024 + 8 * (tid & 15)), offR = (unsigned)tid * 8u, offV = (unsigned)((tid >> 3) * SEQ + 8 * (tid & 7));
    const int dstN = (tid >> 4) * KST + (tid & 15) * 16, dstR = (tid >> 3) * KST + 256 + (tid & 7) * 16, dstV = (tid >> 3) * VST + (tid & 7) * 16;
    const int pr = (r32 & ~0xC) | ((r32 & 4) << 1) | ((r32 & 8) >> 1);
    const int koff = pr * KST + hi * 16, voff = r32 * VST + hi * 16;
    const int ntile = 4 * (qb + 1);
    constexpr float LOG2E = 1.4426950408889634f;
    const float c2 = (MOBA ? 0.08838834764831845f : 0.07216878364870322f) * LOG2E;
    const float sl2 = MOBA ? __builtin_amdgcn_exp2f(-(float)(h + 1)) * LOG2E : 0.f;
    unsigned sel = 0u;
    if constexpr (MOBA) sel = A.SELM[(size_t)(b * NH + h) * SEQ + qpos];
    bool wskip = false;
    if constexpr (MODE == 2) wskip = !__any(qvalid);
    float m = -1e30f, l = 0.f;
    f32x16 o[4];
#pragma unroll
    for (int d = 0; d < 4; ++d) o[d] = (f32x16){};
    if constexpr (MODE == 3) {
        const int nsel = __builtin_popcount(sel); const size_t pbase = ((size_t)(b * NH + h) * SEQ + qpos) * 3;
        float mi[3], li[3];
#pragma unroll
        for (int i = 0; i < 3; ++i) { const f32x2 ml = (i < nsel) ? A.PML[pbase + i] : (f32x2){-1e30f, 0.f}; mi[i] = ml.x; li[i] = ml.y; }
        m = fmaxf(mi[0], fmaxf(mi[1], mi[2]));
        float lsum = 0.f;
#pragma unroll
        for (int i = 0; i < 3; ++i) { const float w = li[i] * __builtin_amdgcn_exp2f(mi[i] - m); lsum += w;
            if (__any(i < nsel && li[i] > 0.f)) { const bf16_t* pp = A.PO + (pbase + i) * 128 + 4 * hi; const bool have = i < nsel && li[i] > 0.f; const float wv = have ? w : 0.f;
#pragma unroll
                for (int d = 0; d < 4; ++d)
#pragma unroll
                    for (int g = 0; g < 4; ++g) { const u32x2 pw = have ? *(const u32x2*)(pp + 32 * d + 8 * g) : (u32x2){0u, 0u};
                        o[d][4 * g] = fmaf(wv, bf_lo(pw.x), o[d][4 * g]); o[d][4 * g + 1] = fmaf(wv, bf_hi(pw.x), o[d][4 * g + 1]); o[d][4 * g + 2] = fmaf(wv, bf_lo(pw.y), o[d][4 * g + 2]); o[d][4 * g + 3] = fmaf(wv, bf_hi(pw.y), o[d][4 * g + 3]); } } }
        l = hi == 0 ? lsum : 0.f;
    }
#pragma unroll
    for (int s = 0; s < NS; ++s) asm volatile("" : "+v"(qr[s]));
    u32x4 sk[3], sv[2];
#define AT_LOAD(kb_) do { const bf16_t* n_ = baseN + (size_t)(kb_) * 1024; sk[0] = *(const u32x4*)(n_ + offN); sk[1] = *(const u32x4*)(n_ + 32 * 1024 + offN); \
                          if constexpr (!MOBA) sk[2] = *(const u32x4*)(baseR + (size_t)(kb_) * ROPE + offR); \
                          const bf16_t* v_ = baseV + (kb_); sv[0] = *(const u32x4*)(v_ + offV); sv[1] = *(const u32x4*)(v_ + (size_t)64 * SEQ + offV); } while (0)
#define AT_WRITE(bf_) do { LAS unsigned char* kb__ = lds + (bf_) * SET; *(LAS u32x4*)(kb__ + dstN) = sk[0]; *(LAS u32x4*)(kb__ + 32 * KST + dstN) = sk[1]; \
                           if constexpr (!MOBA) *(LAS u32x4*)(kb__ + dstR) = sk[2]; \
                           *(LAS u32x4*)(kb__ + KBUF + dstV) = sv[0]; *(LAS u32x4*)(kb__ + KBUF + 64 * VST + dstV) = sv[1]; } while (0)
    auto next_t = [&](int t_) { return t_ + 1; };
    int t = MOBA ? 4 * qb : 0, cb = 0;
    AT_LOAD(t * 64); AT_WRITE(0); __syncthreads();
    for (; t < ntile; ) {
        const int tn = next_t(t);
        const int kb = t * 64;
        LAS unsigned char* Kb = lds + cb * SET; LAS unsigned char* Vb = Kb + KBUF;
        if (tn < ntile) AT_LOAD(tn * 64);
        bool act = kb <= qw0 + 31;
        if constexpr (MODE == 2) act = !wskip;
        if (act) {
            f32x16 p0 = {}, p1 = {};
#pragma unroll
            for (int s = 0; s < NS; ++s) {
                const bf16x8 a0 = *(const LAS bf16x8*)(Kb + koff + s * 32), a1 = *(const LAS bf16x8*)(Kb + koff + 32 * KST + s * 32);
                p0 = mfma32(a0, qr[s], p0); p1 = mfma32(a1, qr[s], p1);
                if ((s & 3) == 3) __builtin_amdgcn_sched_barrier(0); }
            if constexpr (MOBA) {
                const float base0 = sl2 * (float)(kb - qpos + 8 * hi), base1 = base0 + 32.f * sl2;
#pragma unroll
                for (int r = 0; r < 16; ++r) { const float kc = (float)((r & 7) + 16 * (r >> 3));
                    p0[r] = fmaf(kc, sl2, fmaf(p0[r], c2, base0)); p1[r] = fmaf(kc, sl2, fmaf(p1[r], c2, base1)); }
            }
            if (kb + 63 > qw0) {
                const int dq = qpos - kb - 8 * hi;
#pragma unroll
                for (int r = 0; r < 16; ++r) { const int kc = (r & 7) + 16 * (r >> 3); if (kc > dq) p0[r] = NEG; if (kc + 32 > dq) p1[r] = NEG; }
            }
            float mx = fmaxf(p0[0], p1[0]);
#pragma unroll
            for (int r = 1; r < 16; ++r) mx = fmaxf(mx, fmaxf(p0[r], p1[r]));
            mx = xhalf_max(mx);
            const float thr = MOBA ? 11.5f : 11.5f / c2;
            if (!__all(mx <= m + thr)) {
                const float mn = fmaxf(m, mx);
                const float al = __builtin_amdgcn_exp2f(MOBA ? (m - mn) : (m - mn) * c2);
                m = mn; l *= al;
#pragma unroll
                for (int d = 0; d < 4; ++d)
#pragma unroll
                    for (int r = 0; r < 16; ++r) o[d][r] *= al;
            }
            float ps = 0.f;
            if constexpr (MOBA) {
#pragma unroll
                for (int r = 0; r < 16; ++r) { p0[r] = __builtin_amdgcn_exp2f(p0[r] - m); p1[r] = __builtin_amdgcn_exp2f(p1[r] - m); ps += p0[r] + p1[r]; }
            } else {
                const float nm = -m * c2;
#pragma unroll
                for (int r = 0; r < 16; ++r) { p0[r] = __builtin_amdgcn_exp2f(fmaf(p0[r], c2, nm)); p1[r] = __builtin_amdgcn_exp2f(fmaf(p1[r], c2, nm)); ps += p0[r] + p1[r]; }
            }
            l += ps;
            bf16x8 pb[4]; pb[0] = pack8(p0, 0); pb[1] = pack8(p0, 8); pb[2] = pack8(p1, 0); pb[3] = pack8(p1, 8);
#pragma unroll
            for (int d = 0; d < 4; ++d)
#pragma unroll
                for (int s2 = 0; s2 < 4; ++s2) { o[d] = mfma32(*(const LAS bf16x8*)(Vb + voff + d * 32 * VST + s2 * 32), pb[s2], o[d]); if (s2 == 3 && (d & 1)) __builtin_amdgcn_sched_barrier(0); }
        }
        if (tn < ntile) AT_WRITE(cb ^ 1);
        __syncthreads();
        t = tn; cb ^= 1;
    }
#undef AT_LOAD
#undef AT_WRITE
    l += __shfl_xor(l, 32);
    const float inv = l > 0.f ? 1.0f / l : 0.f;
    if constexpr (MODE == 2) {
        if (qvalid) { const int slot = __builtin_popcount(sel & ((1u << qb) - 1u)); const size_t pidx = ((size_t)(b * NH + h) * SEQ + qpos) * 3 + slot;
            if (hi == 0) A.PML[pidx] = (f32x2){m, l};
            bf16_t* pp = A.PO + pidx * 128 + 4 * hi;
#pragma unroll
            for (int d = 0; d < 4; ++d)
#pragma unroll
                for (int g = 0; g < 4; ++g) { u32x2 w; w.x = cvt_pk_bf16(o[d][4 * g] * inv, o[d][4 * g + 1] * inv); w.y = cvt_pk_bf16(o[d][4 * g + 2] * inv, o[d][4 * g + 3] * inv); *(u32x2*)(pp + 32 * d + 8 * g) = w; } }
    } else {
    bf16_t* op = A.O + (tokb + qpos) * DM + (MOBA ? MW : 0) + h * 128 + 4 * hi;
    float ss = 0.f;
#pragma unroll
    for (int d = 0; d < 4; ++d)
#pragma unroll
        for (int g = 0; g < 4; ++g) { const float a0 = o[d][4 * g] * inv, a1 = o[d][4 * g + 1] * inv, a2 = o[d][4 * g + 2] * inv, a3 = o[d][4 * g + 3] * inv;
            ss += (a0 * a0 + a1 * a1) + (a2 * a2 + a3 * a3);
            u32x2 w; w.x = cvt_pk_bf16(a0, a1); w.y = cvt_pk_bf16(a2, a3); *(u32x2*)(op + 32 * d + 8 * g) = w; }
    ss += __shfl_xor(ss, 32);
    if (hi == 0) epi::atomic_add_fx((MOBA ? A.ssb : A.ssa) + tokb + qpos, ss);
    }
}

__device__ __forceinline__ void moba_gate_phase(const Args& A, int gw, int ngw) {
    int tid = threadIdx.x; asm volatile("" : "+v"(tid));
    const int lane = tid & 63, r32 = lane & 31, hi = lane >> 5;
    const float NEG = -__builtin_inff();
    for (int it = gw; it < NB * NH * (SEQ / 32); it += ngw) { const int qt = it & 255, bh = it >> 8, b = bh >> 3, h = bh & 7, qpos = qt * 32 + r32, qb = qt >> 3;
        unsigned sel = 0u;
        bf16x8 qr[8];
        { const bf16_t* qp = A.MQ + ((size_t)b * SEQ + qpos) * MW + h * 128 + hi * 8;
#pragma unroll
          for (int s = 0; s < 8; ++s) qr[s] = *(const bf16x8*)(qp + 16 * s); }
        float q2 = 0.f;
#pragma unroll
        for (int s = 0; s < 8; ++s) { const u32x4 w = __builtin_bit_cast(u32x4, qr[s]);
#pragma unroll
            for (int c = 0; c < 4; ++c) { const float a = bf_lo(w[c]), bb = bf_hi(w[c]); q2 += a * a + bb * bb; } }
        q2 += __shfl_xor(q2, 32);
        if (qb > 0) {
            const bf16_t* kmp = A.KMEAN + ((size_t)((b * NH + h) * 32 + r32)) * 128 + hi * 8;
            f32x16 g = {};
#pragma unroll
            for (int s = 0; s < 8; ++s) g = mfma32(*(const bf16x8*)(kmp + 16 * s), qr[s], g);
            float v1 = NEG, v2 = NEG, v3 = NEG; int i1 = 0, i2 = 0, i3 = 0;
#pragma unroll
            for (int r = 0; r < 16; ++r) { const int j = (r & 3) + 8 * (r >> 2) + 4 * hi; const float x = (j < qb) ? g[r] : NEG;
                if (x > v1) { v3 = v2; i3 = i2; v2 = v1; i2 = i1; v1 = x; i1 = j; } else if (x > v2) { v3 = v2; i3 = i2; v2 = x; i2 = j; } else if (x > v3) { v3 = x; i3 = j; } }
            float pv[3]; int pi[3];
            pv[0] = __shfl_xor(v1, 32); pv[1] = __shfl_xor(v2, 32); pv[2] = __shfl_xor(v3, 32); pi[0] = __shfl_xor(i1, 32); pi[1] = __shfl_xor(i2, 32); pi[2] = __shfl_xor(i3, 32);
#pragma unroll
            for (int k = 0; k < 3; ++k) { const float x = pv[k]; const int j = pi[k];
                if (x > v1 || (x == v1 && j < i1)) { v3 = v2; i3 = i2; v2 = v1; i2 = i1; v1 = x; i1 = j; }
                else if (x > v2 || (x == v2 && j < i2)) { v3 = v2; i3 = i2; v2 = x; i2 = j; }
                else if (x > v3 || (x == v3 && j < i3)) { v3 = x; i3 = j; } }
            sel = (v1 > NEG ? 1u << i1 : 0u) | (v2 > NEG ? 1u << i2 : 0u) | (v3 > NEG ? 1u << i3 : 0u);
        }
        if (hi == 0) { const size_t qi = (size_t)bh * SEQ + qpos; A.SELM[qi] = sel; A.QN[qi] = sqrtf(q2) * 1.001f;
            A.PML[qi * 3] = (f32x2){-1e30f, 0.f}; A.PML[qi * 3 + 1] = (f32x2){-1e30f, 0.f}; A.PML[qi * 3 + 2] = (f32x2){-1e30f, 0.f}; }
    }
}

__device__ __forceinline__ void moba_list_phase(const Args& A, int gw, int ngw) {
    int tid = threadIdx.x; asm volatile("" : "+v"(tid));
    const int lane = tid & 63;
    constexpr float LOG2E = 1.4426950408889634f; const float c2 = 0.08838834764831845f * LOG2E;
    for (int it = gw; it < NB * NH * 32; it += ngw) { const int j = it & 31, bh = it >> 5, h = bh & 7; int n = 0;
        const float sl2 = __builtin_amdgcn_exp2f(-(float)(h + 1)) * LOG2E, kj = A.KMAX[bh * 32 + j];
        unsigned short* lst = A.LIST + (size_t)it * SEQ;
        for (int s0 = 256 * (j + 1); s0 < SEQ; s0 += 64) { const int s = s0 + lane;
            bool on = (A.SELM[(size_t)bh * SEQ + s] >> j) & 1u;
            if (on) { const float bound = A.QN[(size_t)bh * SEQ + s] * (kj + A.KMAX[bh * 32 + (s >> 8)]) * c2 - sl2 * (float)(s - (256 * (j + 1) - 1)); if (bound < -150.f) on = false; }
            const unsigned long long bal = __ballot(on);
            if (on) lst[n + __builtin_popcountll(bal & ((1ull << lane) - 1ull))] = (unsigned short)s;
            n += __builtin_popcountll(bal); }
        if (lane == 0) A.CNT[it] = n; }
}
__device__ __forceinline__ void moba_routed_phase(LAS unsigned char* lds, const Args& A, int vcu, int G) {
    LAS int* pre = (LAS int*)(lds + 120 * 1024);
    { int tid = threadIdx.x; asm volatile("" : "+v"(tid));
      if (tid < 64) { int v[16], s = 0;
#pragma unroll
          for (int i = 0; i < 16; ++i) { v[i] = (A.CNT[tid * 16 + i] + 255) >> 8; s += v[i]; }
          int inc = s;
#pragma unroll
          for (int o_ = 1; o_ < 64; o_ <<= 1) { const int t_ = __shfl_up(inc, o_); if (tid >= o_) inc += t_; }
          int run = inc - s;
#pragma unroll
          for (int i = 0; i < 16; ++i) { pre[tid * 16 + i] = run; run += v[i]; }
          if (tid == 63) pre[1024] = run; }
      __syncthreads(); }
    const int total = pre[1024];
    for (int u = vcu; u < total; u += G) {
        int lo_ = 0, hi_ = 1024;
        while (hi_ - lo_ > 1) { const int mid = (lo_ + hi_) >> 1; if (pre[mid] <= u) lo_ = mid; else hi_ = mid; }
        const int it = lo_, j = it & 31, bh = it >> 5;
        attn_block<128, 2>(lds, A, bh >> 3, bh & 7, j, u - pre[it], A.CNT[it]);
    }
    __syncthreads();
}
__device__ __forceinline__ void mla_phase(LAS unsigned char* lds, const Args& A, int vcu, int G) {
    for (int it = vcu; it < 512; it += G) { const int bh = it >> 4, x = it & 15, b = bh >> 3, h = bh & 7;
        for (int pass = 0; pass < 2; ++pass) attn_block<QKD, 0>(lds, A, b, h, pass ? x : 31 - x); }
}
__device__ __forceinline__ void moba_own_phase(LAS unsigned char* lds, const Args& A, int vcu, int G) {
    for (int it = vcu; it < NB * NH * 32; it += G) attn_block<128, 3>(lds, A, it >> 8, (it >> 5) & 7, it & 31);
}
}
constexpr size_t MiB = 1u << 20;
constexpr size_t WS_CTL = 0, CTL_ZERO_BYTES = 2 * MiB;
constexpr size_t WS_ROPE = 2 * MiB;
constexpr size_t WS_KMEAN = 4 * MiB;
constexpr size_t WS_KMAX = 4 * MiB + 512 * 1024;
constexpr size_t WS_QN = 15 * MiB;
constexpr size_t WS_CNT = 7 * MiB;
constexpr size_t WS_PML = 8 * MiB;
constexpr size_t WS_LIST = 368 * MiB;
constexpr size_t WS_PO = 176 * MiB;
constexpr size_t WS_SELM = 6 * MiB;
constexpr size_t WS_W_IN = 6 * MiB;
constexpr size_t WS_W_UQ = 24 * MiB;
constexpr size_t WS_W_UKV = 27 * MiB;
constexpr size_t WS_W_OUT = 29 * MiB;
constexpr size_t WS_W_PQ = 37 * MiB;
constexpr size_t WS_W_SK = 45 * MiB;
constexpr size_t WS_U = 48 * MiB, WS_V = 112 * MiB;
constexpr size_t WS_US = 46 * MiB, WS_VS = 47 * MiB;
constexpr size_t WS_UP = 820 * MiB;
constexpr size_t WS_T8 = 804 * MiB, WS_S0 = 818 * MiB;
constexpr size_t WS_H8 = 836 * MiB, WS_HS = 900 * MiB;
constexpr size_t WS_PD = 432 * MiB;
constexpr size_t WS_DOT = 804 * MiB;
constexpr size_t WS_Y2 = 304 * MiB;
constexpr size_t WS_H = 176 * MiB;
constexpr size_t WS_QLAT = 304 * MiB, WS_KVLAT = 352 * MiB, WS_KR = 384 * MiB, WS_MQ = 388 * MiB, WS_MK = 452 * MiB, WS_MVT = 516 * MiB;
constexpr size_t WS_QM = 580 * MiB, WS_KM = 676 * MiB, WS_VMT = 740 * MiB;
constexpr size_t WS_O = 804 * MiB;
constexpr size_t WS_IDS = 932 * MiB, WS_G = 948 * MiB, WS_MODP = 964 * MiB, WS_END = 972 * MiB;
constexpr size_t WS_MOD = 5 * MiB;
constexpr size_t WS_Y = WS_QLAT;
constexpr size_t WS_QP = WS_QM;
constexpr size_t WS_SC = WS_QLAT;
static_assert(WS_SC + (size_t)2048 * NT * 4 <= WS_QM && WS_QP + (size_t)NT * DM * 2 <= WS_O, "d_ws overlays");
constexpr int CW_BAR = 1024;
constexpr int CW_XRANK = 6144;
constexpr int CW_SSQ = 8192, CW_SSKV = CW_SSQ + 2 * NT, CW_SSA = CW_SSKV + 2 * NT, CW_SSB = CW_SSA + 2 * NT, CW_SSY = CW_SSB + 2 * NT, CW_SSY2 = CW_SSY + 2 * NT;
static_assert((size_t)(CW_SSY2 + 2 * NT) * 4 <= CTL_ZERO_BYTES, "CTL words inside the memset region");
#define CTL_FX(w) ((epi::fx_t*)(F.ctlf + (w)))

constexpr int NWAVES = 8;
constexpr int RING_BYTES = 131072, LDSCTL_OFF = RING_BYTES, LDS_BYTES = 147456;

#define XB_TMO      128
#define XB_XCNT(j)  (256  + 64 * (j))
#define XB_XSUB(j)  (1280 + 64 * (j))
#define XB_XGEN(j)  (2304 + 64 * (j))
#define XB_TOP      3328
#define XB_TOPGEN   3392
#define XCD_BAR_WORDS 3456
#define XB_SPIN_CAP (1u << 24)
__device__ __forceinline__ unsigned xb_ld(unsigned* p)              { return __hip_atomic_load(p, __ATOMIC_RELAXED, __HIP_MEMORY_SCOPE_AGENT); }
__device__ __forceinline__ unsigned xb_add(unsigned* p, unsigned v) { return __hip_atomic_fetch_add(p, v, __ATOMIC_RELAXED, __HIP_MEMORY_SCOPE_AGENT); }
__device__ __forceinline__ unsigned xb_xcc_id() { return (unsigned)__builtin_amdgcn_s_getreg((3 << 11) | 20) & 0xFu; }
#define XB_SPIN(cond, bar) do { unsigned _sp = 0; while (cond) { __builtin_amdgcn_s_sleep(1); \
    if ((++_sp & 255u) == 0u) { if (xb_ld(&(bar)[XB_TMO])) break; if (_sp > XB_SPIN_CAP) { atomicAdd(&(bar)[XB_TMO], 1u); break; } } } } while (0)
struct XcdBarrier { unsigned* bar; unsigned x; volatile LAS unsigned* st; };
__device__ __forceinline__ XcdBarrier xcd_barrier_post(unsigned* bar, volatile LAS unsigned* st) {
    XcdBarrier b; b.bar = bar; b.x = xb_xcc_id(); b.st = st;
    if (threadIdx.x == 0) (void)xb_add(&bar[XB_XCNT(b.x)], 1u);
    return b;
}
__device__ __forceinline__ void xcd_barrier_complete(unsigned* bar, unsigned x, unsigned& nloc, unsigned& nx) {
    const unsigned G = gridDim.x * gridDim.y * gridDim.z;
    unsigned sum, cnt, mine, sp = 0u;
    for (;;) {
        sum = 0u; cnt = 0u; mine = 0u;
#pragma unroll
        for (unsigned j = 0; j < 16; ++j) { const unsigned c = xb_ld(&bar[XB_XCNT(j)]); sum += c; cnt += (c > 0u) ? 1u : 0u; mine = (j == x) ? c : mine; }
        if (sum == G) break;
        __builtin_amdgcn_s_sleep(1);
        if ((++sp & 255u) == 0u) { if (xb_ld(&bar[XB_TMO])) break; if (sp > XB_SPIN_CAP) { atomicAdd(&bar[XB_TMO], 1u); break; } }
    }
    nloc = mine > 0u ? mine : 1u; nx = cnt > 0u ? cnt : 1u;
}
__device__ __forceinline__ void xcd_barrier(const XcdBarrier& b) {
    asm volatile("s_waitcnt vmcnt(0)" ::: "memory");
    __syncthreads();
    if (threadIdx.x == 0) {
        unsigned* bar = b.bar;
        __builtin_amdgcn_s_waitcnt(0);
        unsigned nloc = b.st[0], nx = b.st[1];
        if (nloc == 0u) { xcd_barrier_complete(bar, b.x, nloc, nx); b.st[0] = nloc; b.st[1] = nx; }
        const unsigned old = xb_add(&bar[XB_XSUB(b.x)], 1u);
        const unsigned gen = old / nloc;
        if (old + 1u == (gen + 1u) * nloc) {
            __builtin_amdgcn_fence(__ATOMIC_RELEASE, "agent");
            asm volatile("s_waitcnt vmcnt(0)" ::: "memory");
            const unsigned og = xb_add(&bar[XB_TOP], 1u);
            const unsigned tg = og / nx;
            if (og + 1u == (tg + 1u) * nx) xb_add(&bar[XB_TOPGEN], 1u);
            else XB_SPIN(xb_ld(&bar[XB_TOPGEN]) == tg, bar);
            __builtin_amdgcn_fence(__ATOMIC_ACQUIRE, "agent");
            xb_add(&bar[XB_XGEN(b.x)], 1u);
            asm volatile("s_waitcnt vmcnt(0)" ::: "memory");
        } else {
            XB_SPIN(xb_ld(&bar[XB_XGEN(b.x)]) == gen, bar);
            __builtin_amdgcn_fence(__ATOMIC_ACQUIRE, "agent");
            asm volatile("s_waitcnt vmcnt(0)" ::: "memory");
        }
    }
    __syncthreads();
}

struct Args { const float* in[21]; float* out; unsigned char* ws; int ph_lo, ph_hi; };
struct Frame {
    LAS unsigned char* lds;
    int vcu, G;
    int xrank, xidx, xn, xloc;
    const struct Args* a; float* out; unsigned char* ws;
    float* ctlf;
};
#define WSP(T, off) ((T*)(F.ws + (off)))
#define LDS_WAIT() asm volatile("s_waitcnt lgkmcnt(0)" ::: "memory")
#define PHASE_TID() int tid_ = threadIdx.x; asm volatile("" : "+v"(tid_)); const int lane = tid_ & 63, wave = __builtin_amdgcn_readfirstlane(tid_ >> 6); (void)lane; (void)wave

__device__ __forceinline__ void tr_item(const float* W, int K, int N, bf16_t* WT, int k0, int n0, int dbase, int dstride, const float* gk, LAS float* scr, int lane) {
#pragma unroll 8
    for (int i = 0; i < 32; ++i) { const int kk = 2 * i + (lane >> 5); float w = W[(size_t)(k0 + kk) * N + n0 + (lane & 31)]; if (gk) w *= gk[kk]; scr[kk * 33 + (lane & 31)] = w; }
    LDS_WAIT(); asm volatile("" ::: "memory");
    const int c = lane & 7;
#pragma unroll
    for (int j = 0; j < 4; ++j) { const int n = (lane >> 3) + 8 * j; const LAS float* s = scr + (8 * c) * 33 + n;
        u32x4 o; o.x = cvt_pk_bf16(s[0 * 33], s[1 * 33]); o.y = cvt_pk_bf16(s[2 * 33], s[3 * 33]); o.z = cvt_pk_bf16(s[4 * 33], s[5 * 33]); o.w = cvt_pk_bf16(s[6 * 33], s[7 * 33]);
        *(u32x4*)(WT + (size_t)(dbase + dstride * n) * K + k0 + 8 * c) = o; }
    LDS_WAIT(); asm volatile("" ::: "memory");
}
__device__ __forceinline__ float silu(float v) { return v / (1.0f + __expf(-v)); }

__device__ __forceinline__ void p0_prologue(Frame& F) {
    PHASE_TID();
    const int gw = F.vcu * NWAVES + wave, NGW = F.G * NWAVES;
    { const float* c = F.a->in[1]; const float* w = F.a->in[2]; float* modp = WSP(float, WS_MODP);
      for (int it = gw; it < 48 * 32; it += NGW) { const int cb = it % 48, kb = it / 48, n = cb * 256 + lane * 4;
          f32x4 acc[4];
#pragma unroll
          for (int b = 0; b < 4; ++b) acc[b] = (f32x4){0.f, 0.f, 0.f, 0.f};
#pragma unroll 4
          for (int kk = 0; kk < 64; ++kk) { const int k = kb * 64 + kk; const f32x4 wv = *(const f32x4*)(w + (size_t)k * (6 * DM) + n);
#pragma unroll
              for (int b = 0; b < 4; ++b) acc[b] += wv * silu(c[b * DM + k]); }
#pragma unroll
          for (int b = 0; b < 4; ++b) *(f32x4*)(modp + ((size_t)kb * 4 + b) * (6 * DM) + n) = acc[b]; } }
}
__device__ __forceinline__ void p0_mod_reduce(Frame& F) {
    PHASE_TID();
    const int gt = (F.vcu * NWAVES + wave) * 64 + lane, NGT = F.G * NWAVES * 64;
    const float* modp = WSP(float, WS_MODP); float* mod = WSP(float, WS_MOD); const float* bias = F.a->in[3];
    for (int i = gt; i < 4 * 6 * DM; i += NGT) { float s = bias[i % (6 * DM)];
#pragma unroll 8
        for (int kb = 0; kb < 32; ++kb) s += modp[(size_t)kb * (4 * 6 * DM) + i];
        mod[i] = s; }
}
__device__ __forceinline__ unsigned pack_i8(f32x4 x) {
    const int a = __float2int_rn(x[0]), b = __float2int_rn(x[1]), c = __float2int_rn(x[2]), d = __float2int_rn(x[3]);
    return ((unsigned)a & 255u) | (((unsigned)b & 255u) << 8) | (((unsigned)c & 255u) << 16) | ((unsigned)d << 24); }
__device__ __forceinline__ void p0_convert(Frame& F) {
    PHASE_TID();
    LAS float* scr = (LAS float*)(F.lds + wave * 16384);
    const int gw = F.vcu * NWAVES + wave, NGW = F.G * NWAVES;
    const int gt = gw * 64 + lane, NGT = NGW * 64;
    { constexpr int I_IN = 32 * 138, I_UQ = 12 * 48, I_UKV = 8 * 64, I_OUT = 32 * 64, I_PQ = 32 * 64, NIT = I_IN + I_UQ + I_UKV + I_OUT + I_PQ;
      for (int it = gw; it < NIT; it += NGW) { int r = it;
          if (r < I_IN) { const int kb = r / 138, nb = r % 138, n0 = nb * 32; int db, ds = 1;
              if (n0 < 1280) db = n0; else if (n0 < 1312) { db = 1280; ds = 2; } else if (n0 < 1344) { db = 1281; ds = 2; } else if (n0 < 2368) db = 1536 + (n0 - 1344); else if (n0 < 3392) db = 2560 + (n0 - 2368); else db = 3584 + (n0 - 3392);
              tr_item(F.a->in[5], DM, 4416, WSP(bf16_t, WS_W_IN), kb * 64, n0, db, ds, nullptr, scr, lane); continue; } r -= I_IN;
          if (r < I_UQ) { const int kb = r / 48, nb = r % 48, n0 = nb * 32, hh = n0 / QKD, j0 = n0 % QKD; int db = n0, ds = 1;
              if (j0 == 128) { db = hh * QKD + 128; ds = 2; } else if (j0 == 160) { db = hh * QKD + 129; ds = 2; }
              tr_item(F.a->in[7], QR, NH * QKD, WSP(bf16_t, WS_W_UQ), kb * 64, n0, db, ds, F.a->in[6] + kb * 64, scr, lane); continue; } r -= I_UQ;
          if (r < I_UKV) { const int kb = r / 64, nb = r % 64, n0 = nb * 32, hh = n0 / 256, j0 = n0 % 256; const int db = (j0 < 128) ? hh * 128 + j0 : 1024 + hh * 128 + (j0 - 128);
              tr_item(F.a->in[9], KVR, 2048, WSP(bf16_t, WS_W_UKV), kb * 64, n0, db, 1, F.a->in[8] + kb * 64, scr, lane); continue; } r -= I_UKV;
          if (r < I_OUT) { const int kb = r / 64, nb = r % 64, k0 = kb * 64; const float* gk = (k0 < MW) ? F.a->in[10] + k0 : F.a->in[11] + (k0 - MW);
              tr_item(F.a->in[12], DM, DM, WSP(bf16_t, WS_W_OUT), k0, nb * 32, nb * 32, 1, gk, scr, lane); continue; } r -= I_OUT;
          { const int kb = r / 64, nb = r % 64; tr_item(F.a->in[15], DM, DM, WSP(bf16_t, WS_W_PQ), kb * 64, nb * 32, nb * 32, 1, nullptr, scr, lane); }
      } }
    { u32x4* z = (u32x4*)(WSP(bf16_t, WS_W_IN) + (size_t)1344 * DM); const int n16 = 192 * DM * 2 / 16;
      for (int i = gt; i < n16; i += NGT) z[i] = (u32x4){0u, 0u, 0u, 0u}; }
    { bf16_t* SK = WSP(bf16_t, WS_W_SK);
      for (int i = gt; i < 2048 * 32; i += NGT) { const int row = i >> 5, c8 = (i & 31) * 8, hh = row >> 8, n = row & 255; u32x4 o = {0u, 0u, 0u, 0u};
          const float* src = nullptr;
          if (n < 128 && c8 < 128) src = F.a->in[16] + ((size_t)(hh * 128 + n)) * 128 + c8;
          else if (n >= 128 && c8 >= 128) src = F.a->in[17] + ((size_t)(hh * 128 + n - 128)) * 128 + (c8 - 128);
          if (src) { const f32x4 a = *(const f32x4*)src, b = *(const f32x4*)(src + 4); o.x = cvt_pk_bf16(a[0], a[1]); o.y = cvt_pk_bf16(a[2], a[3]); o.z = cvt_pk_bf16(b[0], b[1]); o.w = cvt_pk_bf16(b[2], b[3]); }
          *(u32x4*)(SK + (size_t)row * 256 + c8) = o; } }
    { f32x2* tab = WSP(f32x2, WS_ROPE);
      for (int i = gt; i < SEQ * 32; i += NGT) { const int pos = i >> 5, f = i & 31; double pw = 1.0; for (int k_ = 0; k_ < f; ++k_) pw *= 0.7498942093324558273; const float ang = (float)pos * (float)pw;
          const double rev = (double)ang * 0.15915494309189535; const float fr = (float)(rev - __builtin_floor(rev));
          tab[i] = (f32x2){__builtin_amdgcn_cosf(fr), __builtin_amdgcn_sinf(fr)}; } }
    { for (int tb = 0; tb < 2; ++tb) { const float* src = F.a->in[18 + tb]; unsigned char* dst = WSP(unsigned char, tb ? WS_V : WS_U); float* scl = WSP(float, tb ? WS_VS : WS_US);
          for (int r = gw; r < NEXP; r += NGW) { const float* row = src + (size_t)r * DM; f32x4 v[2][4]; float mx = 0.f;
#pragma unroll
              for (int c = 0; c < 2; ++c)
#pragma unroll
                  for (int q = 0; q < 4; ++q) { v[c][q] = *(const f32x4*)(row + c * 1024 + lane * 16 + q * 4); mx = fmaxf(mx, fmaxf(fmaxf(fabsf(v[c][q][0]), fabsf(v[c][q][1])), fmaxf(fabsf(v[c][q][2]), fabsf(v[c][q][3])))); }
#pragma unroll
              for (int o = 1; o < 64; o <<= 1) mx = fmaxf(mx, __shfl_xor(mx, o));
              const float sc = mx > 0.f ? mx * (tb ? 1.0f / 416.0f : 1.0f / 127.0f) : 1.0f, inv = 1.0f / sc;
              if (lane == 0) scl[r] = sc;
#pragma unroll
              for (int c = 0; c < 2; ++c) { u32x4 o;
#pragma unroll
                  for (int q = 0; q < 4; ++q) {
                      if (tb) { int w = 0; w = __builtin_amdgcn_cvt_pk_fp8_f32(v[c][q][0] * inv, v[c][q][1] * inv, w, false); w = __builtin_amdgcn_cvt_pk_fp8_f32(v[c][q][2] * inv, v[c][q][3] * inv, w, true); o[q] = (unsigned)w; }
                      else o[q] = pack_i8(v[c][q] * inv); }
                  *(u32x4*)(dst + (size_t)(8 * c + (lane >> 3)) * ((size_t)NEXP * 128) + (size_t)r * 128 + 16 * (lane & 7)) = o; } } } }
}

__device__ __forceinline__ void p1_rows(Frame& F) {
    PHASE_TID();
    const int gw = F.vcu * NWAVES + wave, NGW = F.G * NWAVES;
    const float* mod = WSP(float, WS_MOD); const float* g = F.a->in[4]; bf16_t* H = WSP(bf16_t, WS_H);
    for (int m = gw; m < NT; m += NGW) { const int b = m / SEQ;
        const f32x4* xr = (const f32x4*)(F.a->in[0] + (size_t)m * DM) + lane; f32x4 v[8]; float s = 0.f;
#pragma unroll
        for (int j = 0; j < 8; ++j) { v[j] = xr[64 * j]; s += (v[j][0] * v[j][0] + v[j][1] * v[j][1]) + (v[j][2] * v[j][2] + v[j][3] * v[j][3]); }
        const float rstd = 1.0f / sqrtf(wave_sum(s) * (1.0f / DM) + EPS);
        const float* sh = mod + b * (6 * DM); const float* sc = sh + DM;
        u32x2* o = (u32x2*)(H + (size_t)m * DM) + lane;
#pragma unroll
        for (int j = 0; j < 8; ++j) { const int e = 4 * (lane + 64 * j); const f32x4 gg = *(const f32x4*)(g + e), s1 = *(const f32x4*)(sc + e), h1 = *(const f32x4*)(sh + e);
            const f32x4 r = v[j] * rstd * gg * (s1 + 1.0f) + h1; u32x2 w; w.x = cvt_pk_bf16(r[0], r[1]); w.y = cvt_pk_bf16(r[2], r[3]); o[64 * j] = w; } }
}

__device__ __forceinline__ void p3_kmean(Frame& F) {
    PHASE_TID();
    const int gw = F.vcu * NWAVES + wave, NGW = F.G * NWAVES, rg = lane >> 4, cl = lane & 15;
    const bf16_t* MK = WSP(bf16_t, WS_MK); bf16_t* KM = WSP(bf16_t, WS_KMEAN);
    for (int it = gw; it < NB * 32 * NH; it += NGW) { const int hh = it & 7, j = (it >> 3) & 31, b = it >> 8;
        const bf16_t* src = MK + ((size_t)b * SEQ + j * 256 + rg) * MW + hh * 128 + cl * 8;
        float a[8];
#pragma unroll
        for (int e = 0; e < 8; ++e) a[e] = 0.f;
        float kmx = 0.f;
#pragma unroll 8
        for (int i = 0; i < 64; ++i) { const u32x4 w = *(const u32x4*)(src + (size_t)(4 * i) * MW);
            const float e0 = bf_lo(w.x), e1 = bf_hi(w.x), e2 = bf_lo(w.y), e3 = bf_hi(w.y), e4 = bf_lo(w.z), e5 = bf_hi(w.z), e6 = bf_lo(w.w), e7 = bf_hi(w.w);
            a[0] += e0; a[1] += e1; a[2] += e2; a[3] += e3; a[4] += e4; a[5] += e5; a[6] += e6; a[7] += e7;
            float q = (e0 * e0 + e1 * e1) + (e2 * e2 + e3 * e3) + (e4 * e4 + e5 * e5) + (e6 * e6 + e7 * e7);
            q += dpp_f<DPP_XOR1>(q); q += dpp_f<DPP_XOR2>(q); q += dpp_f<DPP_HMIRROR>(q); q += dpp_f<DPP_XOR8>(q);
            kmx = fmaxf(kmx, q); }
        kmx = fmaxf(kmx, __shfl_xor(kmx, 16)); kmx = fmaxf(kmx, __shfl_xor(kmx, 32));
        if (lane == 0) WSP(float, WS_KMAX)[(b * NH + hh) * 32 + j] = sqrtf(kmx);
#pragma unroll
        for (int e = 0; e < 8; ++e) { a[e] += __shfl_xor(a[e], 16); a[e] += __shfl_xor(a[e], 32); a[e] *= (1.0f / 256.0f); }
        if (rg == 0) { u32x4 o; o.x = cvt_pk_bf16(a[0], a[1]); o.y = cvt_pk_bf16(a[2], a[3]); o.z = cvt_pk_bf16(a[4], a[5]); o.w = cvt_pk_bf16(a[6], a[7]);
            *(u32x4*)(KM + ((size_t)((b * NH + hh) * 32 + j)) * 128 + cl * 8) = o; } }
}

__device__ __forceinline__ void p6_rows(Frame& F) {
    PHASE_TID();
    const int gw = F.vcu * NWAVES + wave, NGW = F.G * NWAVES;
    const float* mod = WSP(float, WS_MOD); const epi::fx_t* ssy = CTL_FX(CW_SSY); const bf16_t* Y = WSP(bf16_t, WS_Y); bf16_t* H = WSP(bf16_t, WS_H);
    const float* gpost = F.a->in[13]; const float* gpre = F.a->in[14];
    for (int m = gw; m < NT; m += NGW) { const int b = m / SEQ;
        const f32x4* xr = (const f32x4*)(F.a->in[0] + (size_t)m * DM) + lane; const u32x2* yr = (const u32x2*)(Y + (size_t)m * DM) + lane;
        const float* mb = mod + b * (6 * DM); const float ry = 1.0f / sqrtf(epi::fx2f(ssy[m]) * (1.0f / DM) + EPS);
        f32x4 v[8]; float s = 0.f;
#pragma unroll
        for (int j = 0; j < 8; ++j) { const int e = 4 * (lane + 64 * j); const f32x4 x = xr[64 * j]; const u32x2 yw = yr[64 * j];
            const f32x4 yv = {bf_lo(yw.x), bf_hi(yw.x), bf_lo(yw.y), bf_hi(yw.y)};
            const f32x4 g1 = *(const f32x4*)(mb + 2 * DM + e), gp = *(const f32x4*)(gpost + e);
            v[j] = x + g1 * (yv * ry * gp); s += (v[j][0] * v[j][0] + v[j][1] * v[j][1]) + (v[j][2] * v[j][2] + v[j][3] * v[j][3]); }
        const float rstd = 1.0f / sqrtf(wave_sum(s) * (1.0f / DM) + EPS);
        f32x4* xo = (f32x4*)(F.out + (size_t)m * DM) + lane; u32x2* ho = (u32x2*)(H + (size_t)m * DM) + lane;
        unsigned* h8o = (unsigned*)(WSP(unsigned char, WS_H8) + (size_t)m * DM) + lane; float* hso = WSP(float, WS_HS) + (size_t)m * 16;
#pragma unroll
        for (int j = 0; j < 8; ++j) { const int e = 4 * (lane + 64 * j); xo[64 * j] = v[j];
            const f32x4 gg = *(const f32x4*)(gpre + e), s2 = *(const f32x4*)(mb + 4 * DM + e), h2 = *(const f32x4*)(mb + 3 * DM + e);
            const f32x4 r = v[j] * rstd * gg * (s2 + 1.0f) + h2; u32x2 w; w.x = cvt_pk_bf16(r[0], r[1]); w.y = cvt_pk_bf16(r[2], r[3]); ho[64 * j] = w;
            float am = fmaxf(fmaxf(fabsf(r[0]), fabsf(r[1])), fmaxf(fabsf(r[2]), fabsf(r[3])));
            am = fmaxf(am, dpp_f<DPP_XOR1>(am)); am = fmaxf(am, dpp_f<DPP_XOR2>(am)); am = fmaxf(am, dpp_f<DPP_HMIRROR>(am)); am = fmaxf(am, dpp_f<DPP_XOR8>(am)); am = fmaxf(am, __shfl_xor(am, 16));
            const float hsc = am > 0.f ? am * (1.0f / 127.0f) : 1.0f;
            h8o[64 * j] = pack_i8(r * (1.0f / hsc));
            if ((lane & 31) == 0) hso[2 * j + (lane >> 5)] = hsc; } }
}

__device__ __forceinline__ unsigned f2key(float f) { const unsigned u = __float_as_uint(f); return u ^ ((u >> 31) ? 0xffffffffu : 0x80000000u); }
__device__ __forceinline__ float key2f(unsigned k) { return __uint_as_float(k ^ ((k >> 31) ? 0x80000000u : 0xffffffffu)); }
__device__ __forceinline__ unsigned med3u(unsigned a, unsigned b, unsigned c) { unsigned r; asm("v_med3_u32 %0, %1, %2, %3" : "=v"(r) : "v"(a), "v"(b), "v"(c)); return r; }
__device__ __forceinline__ void p9_topk(Frame& F) {
    const _Float16* SC = WSP(_Float16, WS_SC); int* IDS = WSP(int, WS_IDS); float* GW = WSP(float, WS_G); float* UP = WSP(float, WS_UP); const float* US = WSP(float, WS_US); const float* VS = WSP(float, WS_VS);
    PHASE_TID();
    const int hh = wave;
    for (int blk = F.vcu; blk < NT / 64; blk += F.G) { const int tok = blk * 64 + lane;
        unsigned t1[16], t2[16];
#pragma unroll
        for (int i = 0; i < 16; ++i) { t1[i] = 0u; t2[i] = 0u; }
        const unsigned short* spu = (const unsigned short*)(SC + (size_t)(hh * 256) * NT + tok);
        unsigned short xa1[16], xa2[16], xb1[16], xb2[16];
        auto ldb = [&](unsigned short* x1, unsigned short* x2, int n0) {
#pragma unroll
            for (int u = 0; u < 16; ++u) { x1[u] = spu[(size_t)(n0 + u) * NT]; x2[u] = spu[(size_t)(128 + n0 + u) * NT]; } };
        auto ins = [&](const unsigned short* x1, const unsigned short* x2, int n0) {
#pragma unroll
            for (int u = 0; u < 16; ++u) { const float f1 = (float)__builtin_bit_cast(_Float16, x1[u]), f2 = (float)__builtin_bit_cast(_Float16, x2[u]);
                const unsigned k = (f2key(f1) & ~127u) | (unsigned)(127 - (n0 + u)), k2 = (f2key(f2) & ~127u) | (unsigned)(127 - (n0 + u));
#pragma unroll
                for (int i = 15; i >= 1; --i) { t1[i] = med3u(t1[i - 1], t1[i], k); t2[i] = med3u(t2[i - 1], t2[i], k2); }
                t1[0] = max(t1[0], k); t2[0] = max(t2[0], k2); } };
        ldb(xa1, xa2, 0);
#pragma unroll 1
        for (int n0 = 0; n0 < 128; n0 += 32) {
            ldb(xb1, xb2, n0 + 16); __builtin_amdgcn_sched_barrier(0);
            ins(xa1, xa2, n0); __builtin_amdgcn_sched_barrier(0);
            ldb(xa1, xa2, n0 + 32 < 128 ? n0 + 32 : 0); __builtin_amdgcn_sched_barrier(0);
            ins(xb1, xb2, n0 + 16); __builtin_amdgcn_sched_barrier(0);
        }
        unsigned ck[16]; int cid[16];
#pragma unroll
        for (int i = 0; i < 16; ++i) { ck[i] = 0u; cid[i] = 0; }
#pragma unroll
        for (int i = 0; i < 16; ++i) {
            if (F.G + 100 > i) {
                const float v1 = key2f((t1[i] & ~127u) | 64u); const int e1 = (127 - (int)(t1[i] & 127u)) * NKEY;
#pragma unroll
                for (int j = 0; j < 16; ++j) { if ((i + 1) * (j + 1) <= 16) {
                    const float v2 = key2f((t2[j] & ~127u) | 64u); unsigned k = f2key(v1 + v2); int id = e1 + (127 - (int)(t2[j] & 127u));
#pragma unroll
                    for (int q = 0; q < 16; ++q) { const bool gt = k > ck[q]; const unsigned nk = gt ? k : ck[q], lo = gt ? ck[q] : k; const int ni = gt ? id : cid[q], li = gt ? cid[q] : id; ck[q] = nk; cid[q] = ni; k = lo; id = li; } } }
            }
        }
        const float top = key2f(ck[0]); float e[16], sum = 0.f;
#pragma unroll
        for (int q = 0; q < 16; ++q) { e[q] = __expf(key2f(ck[q]) - top); sum += e[q]; }
        const float inv = 1.0f / sum;
        int* ip = IDS + (size_t)tok * 128 + hh * 16; float* gp = GW + (size_t)tok * 128 + hh * 16; float* up = UP + (size_t)tok * 128 + hh * 16;
#pragma unroll
        for (int q = 0; q < 16; q += 4) { *(int4*)(ip + q) = make_int4(cid[q], cid[q + 1], cid[q + 2], cid[q + 3]);
            *(f32x4*)(gp + q) = (f32x4){e[q] * inv * VS[cid[q]], e[q + 1] * inv * VS[cid[q + 1]], e[q + 2] * inv * VS[cid[q + 2]], e[q + 3] * inv * VS[cid[q + 3]]};
            *(f32x4*)(up + q) = (f32x4){US[cid[q]], US[cid[q + 1]], US[cid[q + 2]], US[cid[q + 3]]}; }
    }
}

__device__ __forceinline__ float gelu_erf(float v) {
    const float av = fabsf(v), t = __builtin_amdgcn_rcpf(fmaf(av, 0.2316418882f, 1.0f));
    float q = fmaf(t, 0.5307027145f, -0.7265760135f); q = fmaf(q, t, 0.7107068705f); q = fmaf(q, t, -0.142248368f); q = fmaf(q, t, 0.127414796f); q = q * t;
    const float e = __builtin_amdgcn_exp2f(v * v * -0.72134752044f), mm = v * (q * e);
    return v < 0.f ? mm : v - mm;
}
__device__ __forceinline__ float dot16(u32x4 a, const f32x2* hf, float acc0) {
    f32x2 acc = {acc0, 0.f};
#pragma unroll
    for (int q = 0; q < 4; ++q) { const f32x2 lo = __builtin_amdgcn_cvt_pk_f32_fp8((int)a[q], false), hi = __builtin_amdgcn_cvt_pk_f32_fp8((int)a[q], true);
        acc = __builtin_elementwise_fma(lo, hf[2 * q], acc); acc = __builtin_elementwise_fma(hi, hf[2 * q + 1], acc); }
    return acc.x + acc.y;
}
typedef __attribute__((address_space(1))) const u32x4 g_u32x4;
__device__ __forceinline__ unsigned long long uniform_addr(const void* p) {
    const unsigned long long v = (unsigned long long)p; const unsigned lo = __builtin_amdgcn_readfirstlane((unsigned)v), hi = __builtin_amdgcn_readfirstlane((unsigned)(v >> 32));
    return ((unsigned long long)hi << 32) | lo; }
__device__ __forceinline__ void p11_pdots(Frame& F) {
    PHASE_TID();
    const unsigned char* U = WSP(unsigned char, WS_U); const unsigned char* H8 = WSP(unsigned char, WS_H8); const float* HS = WSP(float, WS_HS);
    const int* IDS = WSP(int, WS_IDS); bf16_t* PD = WSP(bf16_t, WS_PD); bf16_t* dead = WSP(bf16_t, WS_MODP);
    const int lw = F.xrank * NWAVES + wave, nlw = F.xloc * NWAVES;
    for (int sl = F.xidx; sl < 16; sl += F.xn) {
        const unsigned long long Us = uniform_addr(U + (size_t)sl * ((size_t)NEXP * 128)); bf16_t* PDs = PD + (size_t)sl * NT * 128;
        struct Tk { int i0, i1; };
        struct Rw { u32x4 r[16]; u32x4 h; float hs; };
        Tk mA, mB; Rw bA, bB;
        int ln = lane; asm volatile("" : "+v"(ln));
        const unsigned c16 = 16 * (ln & 7);
        auto meta = [&](Tk& m, int tk_) { const int tk = tk_ < NT ? tk_ : lw;
            m.i0 = IDS[(size_t)tk * 128 + ln]; m.i1 = IDS[(size_t)tk * 128 + 64 + ln]; };
        auto issue = [&](Rw& b, const Tk& m, int tk_) { const int tk = tk_ < NT ? tk_ : lw;
            b.h = *(const u32x4*)(H8 + (size_t)tk * DM + sl * 128 + c16); b.hs = HS[(size_t)tk * 16 + sl];
            __builtin_amdgcn_sched_barrier(0);
#pragma unroll
            for (int i = 0; i < 16; ++i) { const int src = (8 * i + (ln >> 3)) & 63; const unsigned ek = (unsigned)__shfl(i < 8 ? m.i0 : m.i1, src);
                b.r[i] = *(g_u32x4*)(Us + (ek * 128u + c16)); } };
        auto compute = [&](const Rw& b, const int tok, const bool real) {
            int d[16];
#pragma unroll
            for (int i = 0; i < 16; ++i) { int a = 0;
#pragma unroll
                for (int q = 0; q < 4; ++q) a = __builtin_amdgcn_sdot4((int)b.r[i][q], (int)b.h[q], a, false);
                d[i] = a; }
            int r8[8], r4[4], r2[2];
            { const bool up = ln & 4;
#pragma unroll
              for (int j = 0; j < 8; ++j) { const int snd = up ? d[j] : d[j + 8], keep = up ? d[j + 8] : d[j]; r8[j] = keep + dpp_i<DPP_HMIRROR>(snd); } }
            { const bool up = ln & 2;
#pragma unroll
              for (int j = 0; j < 4; ++j) { const int snd = up ? r8[j] : r8[j + 4], keep = up ? r8[j + 4] : r8[j]; r4[j] = keep + dpp_i<DPP_XOR2>(snd); } }
            { const bool up = ln & 1;
#pragma unroll
              for (int j = 0; j < 2; ++j) { const int snd = up ? r4[j] : r4[j + 2], keep = up ? r4[j + 2] : r4[j]; r2[j] = keep + dpp_i<DPP_XOR1>(snd); } }
            bf16_t* pp = (real ? PDs + (size_t)tok * 128 : dead) + 2 * ln;
            *(unsigned*)pp = cvt_pk_bf16((float)r2[0] * b.hs, (float)r2[1] * b.hs);
        };
        if (lw < NT) {
            meta(mA, lw); meta(mB, lw + nlw);
            __builtin_amdgcn_sched_barrier(0);
            issue(bA, mA, lw); meta(mA, lw + 2 * nlw);
            __builtin_amdgcn_sched_barrier(0);
            for (int tok = lw; tok < NT; tok += 2 * nlw) {
                issue(bB, mB, tok + nlw); meta(mB, tok + 3 * nlw);
                __builtin_amdgcn_sched_barrier(0);
                compute(bA, tok, true);
                __builtin_amdgcn_sched_barrier(0);
                issue(bA, mA, tok + 2 * nlw); meta(mA, tok + 4 * nlw);
                __builtin_amdgcn_sched_barrier(0);
                compute(bB, tok + nlw, tok + nlw < NT);
                __builtin_amdgcn_sched_barrier(0);
            }
        }
    }
}
__device__ __forceinline__ void p11_coef(Frame& F) {
    PHASE_TID();
    const bf16_t* PD = WSP(bf16_t, WS_PD); const float* UP = WSP(float, WS_UP); const float* GW = WSP(float, WS_G); unsigned char* T8 = WSP(unsigned char, WS_T8); float* S0 = WSP(float, WS_S0);
    const int gt = (F.vcu * NWAVES + wave) * 64 + lane, NGT = F.G * NWAVES * 64;
    for (int i = gt; i < NT * 128 / 4; i += NGT) { f32x4 s = {0.f, 0.f, 0.f, 0.f};
#pragma unroll
        for (int sl = 0; sl < 16; ++sl) { const u32x2 w = *(const u32x2*)(PD + (size_t)sl * NT * 128 + (size_t)i * 4); s += (f32x4){bf_lo(w.x), bf_hi(w.x), bf_lo(w.y), bf_hi(w.y)}; }
        const int p0 = (i & 31) * 4, k0 = 16 * ((p0 >> 1) & 7) + (p0 >> 4); const int t = i >> 5; const size_t tb = (size_t)t * 128;
        float a[4];
#pragma unroll
        for (int e_ = 0; e_ < 4; ++e_) { const size_t o = tb + k0 + 8 * e_; a[e_] = gelu_erf(s[e_] * UP[o]) * GW[o]; }
        float am = fmaxf(fmaxf(fabsf(a[0]), fabsf(a[1])), fmaxf(fabsf(a[2]), fabsf(a[3])));
        am = fmaxf(am, dpp_f<DPP_XOR1>(am)); am = fmaxf(am, dpp_f<DPP_XOR2>(am)); am = fmaxf(am, dpp_f<DPP_HMIRROR>(am)); am = fmaxf(am, dpp_f<DPP_XOR8>(am)); am = fmaxf(am, __shfl_xor(am, 16));
        const float s0 = am > 0.f ? am * (1.0f / 256.0f) : 1.0f, inv = 1.0f / s0;
        if ((lane & 31) == 0) S0[t] = s0;
        unsigned q0 = 0u, q1 = 0u;
#pragma unroll
        for (int e_ = 0; e_ < 4; ++e_) { const float x = a[e_] * inv;
            const int w0 = __builtin_amdgcn_cvt_pk_fp8_f32(x, 0.f, 0, false) & 255; const f32x2 d0 = __builtin_amdgcn_cvt_pk_f32_fp8(w0, false); const float r1 = (x - d0.x) * 16.0f;
            const int w1 = __builtin_amdgcn_cvt_pk_fp8_f32(r1, 0.f, 0, false) & 255;
            q0 |= (unsigned)w0 << (8 * e_); q1 |= (unsigned)w1 << (8 * e_); }
        { unsigned char* tp = T8 + (size_t)t * 256 + 16 * (k0 & 7) + (k0 >> 3); *(unsigned*)tp = q0; *(unsigned*)(tp + 128) = q1; } }
}
__device__ __forceinline__ void p12_axpy(Frame& F) {
    PHASE_TID();
    const unsigned char* V = WSP(unsigned char, WS_V); const unsigned char* T8 = WSP(unsigned char, WS_T8); const float* S0 = WSP(float, WS_S0);
    const int* IDS = WSP(int, WS_IDS); bf16_t* Y2 = WSP(bf16_t, WS_Y2); bf16_t* dead = WSP(bf16_t, WS_MODP);
    const int lw = F.xrank * NWAVES + wave, nlw = F.xloc * NWAVES;
    for (int sl = F.xidx; sl < 16; sl += F.xn) {
        const unsigned long long Vs = uniform_addr(V + (size_t)sl * ((size_t)NEXP * 128));
        struct Tk { int i0, i1; };
        struct Rw { u32x4 r[16]; u32x4 ta; float s0; };
        Tk mA, mB; Rw bA, bB;
        int ln = lane; asm volatile("" : "+v"(ln));
        const unsigned c16 = 16 * (ln & 7);
        const int mrow = ln & 15, kb = ln >> 4;
        const bool tv = mrow < 4;
        const int toff = tv ? (mrow & 1) * 128 + 16 * (2 * kb + (mrow >> 1)) : 0;
        auto meta = [&](Tk& m, int tk_) { const int tk = tk_ < NT ? tk_ : lw;
            const size_t o = (size_t)tk * 128 + ln; m.i0 = IDS[o]; m.i1 = IDS[o + 64]; };
        auto issue = [&](Rw& b, const Tk& m, int tk_) { const int tk = tk_ < NT ? tk_ : lw;
#pragma unroll
            for (int i = 0; i < 16; ++i) { const int src = (8 * i + (ln >> 3)) & 63; const unsigned ek = (unsigned)__shfl(i < 8 ? m.i0 : m.i1, src);
                b.r[i] = *(g_u32x4*)(Vs + (ek * 128u + c16)); }
            b.ta = *(const u32x4*)(T8 + (size_t)tk * 256 + toff); b.s0 = S0[tk]; };
        auto compute = [&](const Rw& b, const int tok, const bool real) {
            const unsigned a0 = tv ? b.ta.x : 0u, a1 = tv ? b.ta.y : 0u, a2 = tv ? b.ta.z : 0u, a3 = tv ? b.ta.w : 0u;
            const long av0 = (long)(((unsigned long long)a1 << 32) | a0), av1 = (long)(((unsigned long long)a3 << 32) | a2);
            unsigned pk[8];
#pragma unroll
            for (int hf = 0; hf < 2; ++hf) {
                f32x4 acc[8];
#pragma unroll
                for (int x = 0; x < 8; ++x) acc[x] = (f32x4){0.f, 0.f, 0.f, 0.f};
#pragma unroll
                for (int qq = 0; qq < 2; ++qq) { const int q = 2 * hf + qq;
#pragma unroll
                    for (int be = 0; be < 2; ++be) {
                        unsigned cl[4], ch[4];
                        { const unsigned r0 = b.r[8 * be][q], r1 = b.r[8 * be + 1][q], r2 = b.r[8 * be + 2][q], r3 = b.r[8 * be + 3][q];
                          const unsigned t01l = __builtin_amdgcn_perm(r1, r0, 0x05010400u), t01h = __builtin_amdgcn_perm(r1, r0, 0x07030602u), t23l = __builtin_amdgcn_perm(r3, r2, 0x05010400u), t23h = __builtin_amdgcn_perm(r3, r2, 0x07030602u);
                          cl[0] = __builtin_amdgcn_perm(t23l, t01l, 0x05040100u); cl[1] = __builtin_amdgcn_perm(t23l, t01l, 0x07060302u); cl[2] = __builtin_amdgcn_perm(t23h, t01h, 0x05040100u); cl[3] = __builtin_amdgcn_perm(t23h, t01h, 0x07060302u); }
                        { const unsigned r0 = b.r[8 * be + 4][q], r1 = b.r[8 * be + 5][q], r2 = b.r[8 * be + 6][q], r3 = b.r[8 * be + 7][q];
                          const unsigned t01l = __builtin_amdgcn_perm(r1, r0, 0x05010400u), t01h = __builtin_amdgcn_perm(r1, r0, 0x07030602u), t23l = __builtin_amdgcn_perm(r3, r2, 0x05010400u), t23h = __builtin_amdgcn_perm(r3, r2, 0x07030602u);
                          ch[0] = __builtin_amdgcn_perm(t23l, t01l, 0x05040100u); ch[1] = __builtin_amdgcn_perm(t23l, t01l, 0x07060302u); ch[2] = __builtin_amdgcn_perm(t23h, t01h, 0x05040100u); ch[3] = __builtin_amdgcn_perm(t23h, t01h, 0x07060302u); }
#pragma unroll
                        for (int x = 0; x < 4; ++x) { const long bv = (long)(((unsigned long long)ch[x] << 32) | cl[x]);
                            acc[4 * qq + x] = __builtin_amdgcn_mfma_f32_16x16x32_fp8_fp8(be ? av1 : av0, bv, acc[4 * qq + x], 0, 0, 0); } } }
                float yv[8];
                const bool lo8 = (ln & 8) == 0;
#pragma unroll
                for (int x = 0; x < 8; ++x) { const float v = lo8 ? acc[x][0] + acc[x][1] * 0.0625f : acc[x][2] + acc[x][3] * 0.0625f;
                    yv[x] = b.s0 * (v + __uint_as_float(__builtin_amdgcn_update_dpp(0u, __float_as_uint(v), DPP_XOR8, 0xf, 0xf, true))); }
#pragma unroll
                for (int x = 0; x < 4; ++x) pk[4 * hf + x] = cvt_pk_bf16(yv[2 * x], yv[2 * x + 1]);
            }
            if (ln < 8) { bf16_t* yp = (real ? Y2 + ((size_t)sl * NT + tok) * 128 : dead) + 16 * ln;
                *(u32x4*)yp = (u32x4){pk[0], pk[1], pk[2], pk[3]}; *(u32x4*)(yp + 8) = (u32x4){pk[4], pk[5], pk[6], pk[7]}; }
        };
        if (lw < NT) {
            meta(mA, lw); meta(mB, lw + nlw);
            __builtin_amdgcn_sched_barrier(0);
            issue(bA, mA, lw); meta(mA, lw + 2 * nlw);
            __builtin_amdgcn_sched_barrier(0);
            for (int tok = lw; tok < NT; tok += 2 * nlw) {
                issue(bB, mB, tok + nlw); meta(mB, tok + 3 * nlw);
                __builtin_amdgcn_sched_barrier(0);
                compute(bA, tok, true);
                __builtin_amdgcn_sched_barrier(0);
                issue(bA, mA, tok + 2 * nlw); meta(mA, tok + 4 * nlw);
                __builtin_amdgcn_sched_barrier(0);
                compute(bB, tok + nlw, tok + nlw < NT);
                __builtin_amdgcn_sched_barrier(0);
            }
        }
    }
}
__device__ __forceinline__ void p13_rows(Frame& F) {
    PHASE_TID();
    const int gw = F.vcu * NWAVES + wave, NGW = F.G * NWAVES;
    const float* mod = WSP(float, WS_MOD); const bf16_t* Y2 = WSP(bf16_t, WS_Y2); const float* gpost = F.a->in[20];
    for (int m = gw; m < NT; m += NGW) { const int b = m / SEQ;
        f32x4* xr = (f32x4*)(F.out + (size_t)m * DM) + lane; const bf16_t* yr = Y2 + ((size_t)(lane >> 5) * NT + m) * 128 + 4 * (lane & 31);
        const float* g2 = mod + b * (6 * DM) + 5 * DM;
        u32x2 yw[8]; float s = 0.f;
#pragma unroll
        for (int j = 0; j < 8; ++j) yw[j] = *(const u32x2*)(yr + (size_t)(2 * j) * NT * 128);
#pragma unroll
        for (int j = 0; j < 8; ++j) { const float a = bf_lo(yw[j].x), b_ = bf_hi(yw[j].x), c = bf_lo(yw[j].y), d = bf_hi(yw[j].y); s += (a * a + b_ * b_) + (c * c + d * d); }
        const float ry = 1.0f / sqrtf(wave_sum(s) * (1.0f / DM) + EPS);
#pragma unroll
        for (int j = 0; j < 8; ++j) { const int e = 4 * (lane + 64 * j); const f32x4 x = xr[64 * j];
            const f32x4 yv = {bf_lo(yw[j].x), bf_hi(yw[j].x), bf_lo(yw[j].y), bf_hi(yw[j].y)};
            const f32x4 gg = *(const f32x4*)(g2 + e), gp = *(const f32x4*)(gpost + e);
            xr[64 * j] = x + gg * (yv * ry * gp); } }
}
constexpr int N_PHASES = 15;

__global__ void __launch_bounds__(NWAVES * 64, 2) hymba_fwd(Args args) {
    extern __shared__ __attribute__((aligned(16))) unsigned char lds_raw[];
    Frame F;
    F.lds = (LAS unsigned char*)lds_raw;
    F.G = gridDim.x; { const int bx = blockIdx.x; F.vcu = (F.G % 8 == 0) ? (bx % 8) * (F.G / 8) + bx / 8 : bx; }
    F.a = &args;
    F.out = args.out; F.ws = args.ws; F.ctlf = (float*)(args.ws + WS_CTL);
    volatile LAS unsigned* MISC = (volatile LAS unsigned*)(F.lds + LDSCTL_OFF);
    for (int u = threadIdx.x; u < (LDS_BYTES - LDSCTL_OFF) / 4; u += NWAVES * 64) ((LAS unsigned*)(F.lds + LDSCTL_OFF))[u] = 0u;
    __syncthreads();
    const int lo = args.ph_lo, hi = args.ph_hi;
    XcdBarrier bar; bar.bar = (unsigned*)(F.ctlf) + CW_BAR; bar.x = 0; bar.st = MISC + 8;
    if (hi - lo > 1) bar = xcd_barrier_post((unsigned*)(F.ctlf) + CW_BAR, MISC + 8);
    if (threadIdx.x == 0) MISC[0] = xb_add((unsigned*)(F.ctlf) + CW_XRANK + 64 * (xb_xcc_id() & 15u), 1u);
    F.xrank = 0; F.xidx = 0; F.xn = 1; F.xloc = 1;
#ifndef PH_MASK
#define PH_MASK 0x7fff
#endif
#define IN(k) (((PH_MASK >> (k)) & 1) && lo <= (k) && (k) < hi)
#define SEAM(k) do { if (IN(k) && IN((k) + 1)) xcd_barrier(bar); } while (0)
    LAS unsigned char* ring = F.lds;
    const int cid = (int)blockIdx.x;

    if (IN(0)) { p0_prologue(F); } SEAM(0);
    if (IN(1)) { p0_mod_reduce(F); p0_convert(F); } SEAM(1);
    if (IN(2)) { p1_rows(F); } SEAM(2);
    if (IN(3)) {
        { pg8::Gemm g{WSP(bf16_t, WS_H), WSP(bf16_t, WS_W_IN), DM, DM, DM, 0}; pg8::StaticOrder S; S.init(NT, 14 * 256, F.G, cid);
          epi::EpiProj E{WSP(bf16_t, WS_QLAT), WSP(bf16_t, WS_KVLAT), WSP(bf16_t, WS_KR), WSP(bf16_t, WS_MQ), WSP(bf16_t, WS_MK), CTL_FX(CW_SSQ), CTL_FX(CW_SSKV), WSP(f32x2, WS_ROPE)};
          pg8::gemm_phase(ring, g, S, E); }
        { pg8::Gemm g{WSP(bf16_t, WS_W_IN) + (size_t)3584 * DM, WSP(bf16_t, WS_H), DM, DM, DM, 0}; pg8::StaticOrder S; S.init(1024, NT, F.G, cid);
          epi::EpiVT E{WSP(bf16_t, WS_MVT), nullptr, 0.f};
          pg8::gemm_phase(ring, g, S, E); }
    } SEAM(3);
    if (IN(4)) {
        { pg8::Gemm g{WSP(bf16_t, WS_QLAT), WSP(bf16_t, WS_W_UQ), QR, QR, QR, 0}; pg8::StaticOrder S; S.init(NT, NH * QKD, F.G, cid);
          epi::EpiQ E{WSP(bf16_t, WS_QM), CTL_FX(CW_SSQ), WSP(f32x2, WS_ROPE)};
          pg8::gemm_phase(ring, g, S, E); }
        { pg8::Gemm g{WSP(bf16_t, WS_KVLAT), WSP(bf16_t, WS_W_UKV), KVR, KVR, KVR, 0}; pg8::StaticOrder S; S.init(NT, 1024, F.G, cid);
          epi::EpiRow E{WSP(bf16_t, WS_KM), 1024, CTL_FX(CW_SSKV), 1.0f / KVR};
          pg8::gemm_phase(ring, g, S, E); }
        { pg8::Gemm g{WSP(bf16_t, WS_W_UKV) + (size_t)1024 * KVR, WSP(bf16_t, WS_KVLAT), KVR, KVR, KVR, 0}; pg8::StaticOrder S; S.init(1024, NT, F.G, cid);
          epi::EpiVT E{WSP(bf16_t, WS_VMT), CTL_FX(CW_SSKV), 1.0f / KVR};
          pg8::gemm_phase(ring, g, S, E); }
        p3_kmean(F);
    } SEAM(4);
    if (IN(5)) {
        attn::Args A{WSP(bf16_t, WS_QM), WSP(bf16_t, WS_KM), WSP(bf16_t, WS_KR), WSP(bf16_t, WS_VMT), WSP(bf16_t, WS_MQ), WSP(bf16_t, WS_MK), WSP(bf16_t, WS_MVT), WSP(bf16_t, WS_KMEAN), WSP(float, WS_KMAX), WSP(unsigned, WS_SELM), WSP(unsigned short, WS_LIST), WSP(int, WS_CNT), WSP(float, WS_QN), WSP(bf16_t, WS_PO), WSP(f32x2, WS_PML),
                     WSP(bf16_t, WS_O), CTL_FX(CW_SSA), CTL_FX(CW_SSB)};
        { PHASE_TID(); attn::moba_gate_phase(A, F.vcu * NWAVES + wave, F.G * NWAVES); }
        attn::mla_phase(ring, A, F.vcu, F.G);
        xcd_barrier(bar);
        { PHASE_TID(); attn::moba_list_phase(A, F.vcu * NWAVES + wave, F.G * NWAVES); }
        xcd_barrier(bar);
        attn::moba_routed_phase(ring, A, F.vcu, F.G);
        xcd_barrier(bar);
        attn::moba_own_phase(ring, A, F.vcu, F.G);
    } SEAM(5);
    if (IN(6)) {
        pg8::Gemm g{WSP(bf16_t, WS_O), WSP(bf16_t, WS_W_OUT), DM, DM, DM, 0}; pg8::StaticOrder S; S.init(NT, DM, F.G, cid);
        epi::EpiOut E{WSP(bf16_t, WS_Y), CTL_FX(CW_SSA), CTL_FX(CW_SSB), CTL_FX(CW_SSY)};
        pg8::gemm_phase(ring, g, S, E);
    } SEAM(6);
    if (IN(7)) { p6_rows(F); } SEAM(7);
    if (IN(8)) {
        pg8::Gemm g{WSP(bf16_t, WS_H), WSP(bf16_t, WS_W_PQ), DM, DM, DM, 0}; pg8::StaticOrder S; S.init(NT, DM, F.G, cid);
        epi::EpiRow E{WSP(bf16_t, WS_QP), DM, nullptr, 0.f};
        pg8::gemm_phase(ring, g, S, E);
    } SEAM(8);
    if (IN(9)) {
        pg8::Gemm g{WSP(bf16_t, WS_W_SK), WSP(bf16_t, WS_QP), 256, DM, 256, 256}; pg8::StaticOrder S; S.init(2048, NT, F.G, cid);
        epi::EpiSc E{WSP(_Float16, WS_SC)};
        pg8::gemm_phase(ring, g, S, E);
    } SEAM(9);
    if (IN(10)) { p9_topk(F); } SEAM(10);
    if (IN(11) || IN(13)) {
        if (threadIdx.x == 0) { unsigned* bw = (unsigned*)(F.ctlf) + CW_BAR; unsigned idx = 0u, nx = 0u, mine = 1u;
            for (unsigned j = 0; j < 16; ++j) { const unsigned c = xb_ld(&bw[XB_XCNT(j)]); if (c > 0u) { if (j < bar.x) ++idx; ++nx; } if (j == bar.x) mine = c > 0u ? c : 1u; }
            MISC[1] = idx; MISC[2] = nx > 0u ? nx : 1u; MISC[3] = mine; }
        __syncthreads();
        F.xrank = (int)MISC[0]; F.xidx = (int)MISC[1]; F.xn = (int)MISC[2]; F.xloc = (int)MISC[3];
        if (F.xrank >= F.xloc) F.xrank = F.xrank % F.xloc;
    }
    if (IN(11)) { p11_pdots(F); } SEAM(11);
    if (IN(12)) { p11_coef(F); } SEAM(12);
    if (IN(13)) { p12_axpy(F); } SEAM(13);
    if (IN(14)) { p13_rows(F); }
#undef IN
#undef SEAM
}

extern "C" void kernel_launch(void* const* d_in, const int* in_sizes, int n_in, void* d_out, int out_size, void* d_ws, size_t ws_size, hipStream_t stream) {
    static int grid = 0;
    if (grid == 0) {
        if (n_in != 21 || out_size != NT * DM || ws_size < WS_END) { fprintf(stderr, "kernel_launch: unexpected shapes (n_in %d, out %d, ws %zu)\n", n_in, out_size, ws_size); grid = -1; return; }
        int dev = 0, cus = 0, per_cu = 0;
        if (hipGetDevice(&dev) != hipSuccess || hipDeviceGetAttribute(&cus, hipDeviceAttributeMultiprocessorCount, dev) != hipSuccess) { grid = -1; return; }
        if (hipFuncSetAttribute((const void*)hymba_fwd, hipFuncAttributeMaxDynamicSharedMemorySize, LDS_BYTES) != hipSuccess) { fprintf(stderr, "kernel_launch: hipFuncSetAttribute failed\n"); grid = -1; return; }
        if (hipOccupancyMaxActiveBlocksPerMultiprocessor(&per_cu, (const void*)hymba_fwd, NWAVES * 64, LDS_BYTES) != hipSuccess || per_cu < 1)
            fprintf(stderr, "kernel_launch: occupancy query reports %d workgroups per CU\n", per_cu);
        (void)hipGetLastError();
        grid = cus;
    }
    if (grid < 0) return;
    (void)hipMemsetAsync((char*)d_ws + WS_CTL, 0, CTL_ZERO_BYTES, stream);
    Args a{};
    for (int i = 0; i < 21; ++i) a.in[i] = (const float*)d_in[i];
    a.out = (float*)d_out; a.ws = (unsigned char*)d_ws;
#if MK_N_LAUNCHES == 1
    a.ph_lo = 0; a.ph_hi = N_PHASES;
    hipLaunchKernelGGL(hymba_fwd, dim3(grid), dim3(NWAVES * 64), LDS_BYTES, stream, a);
#else
    for (int p = 0; p < N_PHASES; ++p) { a.ph_lo = p; a.ph_hi = p + 1; hipLaunchKernelGGL(hymba_fwd, dim3(grid), dim3(NWAVES * 64), LDS_BYTES, stream, a); }
#endif
}
```

```cpp
#include <hip/hip_runtime.h>
#include <cstdio>
#include <cstdint>
#include <cmath>
#include <type_traits>

#ifndef MK_N_LAUNCHES
#define MK_N_LAUNCHES 1
#endif

#define LAS __attribute__((address_space(3)))
#define GAS __attribute__((address_space(1)))
typedef unsigned short bf16_t;
typedef short bf16x8 __attribute__((ext_vector_type(8)));
typedef float f32x4 __attribute__((ext_vector_type(4)));
typedef float f32x2 __attribute__((ext_vector_type(2)));
typedef float f32x16 __attribute__((ext_vector_type(16)));
typedef unsigned u32x4 __attribute__((ext_vector_type(4)));
typedef unsigned u32x2 __attribute__((ext_vector_type(2)));
typedef __bf16 bf2_t __attribute__((ext_vector_type(2)));

constexpr int NB = 4, SEQ = 8192, DM = 2048, NT = NB * SEQ;
constexpr int QR = 768, KVR = 512, ROPE = 64, NOPE = 128, QKD = 192, VD = 128, NH = 8;
constexpr int MW = 1024;
constexpr int NEXP = 16384, PK = 16, NKEY = 128;
constexpr float EPS = 1e-6f;

__device__ __forceinline__ unsigned cvt_pk_bf16(float lo, float hi) { unsigned r; asm volatile("v_cvt_pk_bf16_f32 %0, %1, %2" : "=v"(r) : "v"(lo), "v"(hi)); return r; }
__device__ __forceinline__ float bf_lo(unsigned w) { return __uint_as_float(w << 16); }
__device__ __forceinline__ float bf_hi(unsigned w) { return __uint_as_float(w & 0xffff0000u); }
template <int CTRL> __device__ __forceinline__ float dpp_f(float x) { return __uint_as_float(__builtin_amdgcn_update_dpp(0u, __float_as_uint(x), CTRL, 0xf, 0xf, false)); }
template <int CTRL> __device__ __forceinline__ int dpp_i(int x) { return (int)__builtin_amdgcn_update_dpp(0u, (unsigned)x, CTRL, 0xf, 0xf, false); }
#define DPP_XOR1 0xB1
#define DPP_XOR2 0x4E
#define DPP_HMIRROR 0x141
#define DPP_XOR8 0x128
__device__ __forceinline__ float sum_x16(float x) { auto r = __builtin_amdgcn_permlane16_swap(__float_as_uint(x), __float_as_uint(x), false, false); return __uint_as_float(r[0]) + __uint_as_float(r[1]); }
__device__ __forceinline__ float sum_x32(float x) { auto r = __builtin_amdgcn_permlane32_swap(__float_as_uint(x), __float_as_uint(x), false, false); return __uint_as_float(r[0]) + __uint_as_float(r[1]); }
__device__ __forceinline__ float wave_sum(float v) {
    v += dpp_f<DPP_XOR1>(v); v += dpp_f<DPP_XOR2>(v); v += dpp_f<DPP_HMIRROR>(v); v += dpp_f<DPP_XOR8>(v);
    return sum_x32(sum_x16(v));
}

namespace pg8 {
constexpr int BM = 256, BK = 64, HALF = 128, HTB = HALF * BK * 2  , STAGE_BYTES = 8 * HTB, NXCD = 8, WGM = 8;

__host__ __device__ __forceinline__ int lds_byte(int r, int c) { const int st = (r >> 4) * 2 + (c >> 5), rr = r & 15, cc = c & 31, ob = rr * 64 + cc * 2; return st * 1024 + (ob ^ (((ob >> 9) & 1) << 5)); }
__host__ __device__ __forceinline__ void stage_rc(int b, int& R, int& C) { const int st = b / 1024, sb = b % 1024, swz = sb ^ (((sb >> 9) & 1) << 5); R = (st >> 1) * 16 + swz / 64; C = (st & 1) * 32 + (swz % 64) / 2; }
__host__ __device__ __forceinline__ int perm32(int rho) { const int n = rho >> 4, i = rho & 15; return 8 * (i >> 2) + 4 * n + (i & 3); }

struct Unit { int pm, pn; };
struct Gemm { const bf16_t* A; const bf16_t* Bt; int lda, ldb, K, bko; };

struct StaticOrder {
    int nM, nN, nwg, G, c;
    __host__ __device__ void init(int M, int N, int G_, int c_) { nM = M / BM; nN = N / BM; nwg = nM * nN; G = G_; c = c_; }
    __host__ __device__ bool next(int i, Unit& u) const {
        const long L = (long)i * G + c; if (L >= nwg) return false;
        int wgid = (int)L; { const int q = nwg / NXCD, r = nwg % NXCD, xcd = wgid % NXCD, off = wgid / NXCD; wgid = (xcd < r ? xcd * (q + 1) : r * (q + 1) + (xcd - r) * q) + off; }
        const int nig = WGM * nN, gid = wgid / nig, fm = gid * WGM, gsz = (nM - fm) < WGM ? (nM - fm) : WGM;
        u.pm = fm + ((wgid % nig) % gsz); u.pn = (wgid % nig) / gsz; return true;
    }
};

template <class Epi, class Sched>
__device__ __forceinline__ void gemm_phase(LAS unsigned char* lds, const Gemm g, const Sched& S, const Epi& E) {
    int tid = threadIdx.x; asm volatile("" : "+v"(tid));
    const int wid = __builtin_amdgcn_readfirstlane(tid >> 6), lane = tid & 63, wr = wid >> 2, wc = wid & 3, fr = lane & 15, fq = lane >> 4;
    const int K = g.K, nt = K / BK;
    unsigned voffA[2], voffB[2];
#pragma unroll
    for (int i = 0; i < 2; ++i) { int R, C; stage_rc(tid * 16 + i * 8192, R, C); const int Rb = (R & ~31) + perm32(R & 31);
        voffA[i] = (unsigned)(R * g.lda + C) * 2u; voffB[i] = (unsigned)(Rb * g.ldb + C) * 2u; }
    const size_t kstep = (size_t)(BK * 2);
    const size_t hstepA = (size_t)HALF * g.lda * 2, hstepB = (size_t)HALF * g.ldb * 2;
    const size_t tstepA = 2 * hstepA, tstepB = 2 * hstepB;
    const unsigned ldsw = (unsigned)wid * 1024u;
    const int aoff = lds_byte(wr * 64 + fr, fq * 8), boff = lds_byte(wc * 32 + fr, fq * 8);
#define PG8_SA(b, h) (((b) * 2 + (h)) * HTB)
#define PG8_SB(b, h) ((4 + (b) * 2 + (h)) * HTB)
#define PG8_STAGE(bufoff, gbase, voff) do { _Pragma("unroll") for (int _i = 0; _i < 2; ++_i) \
        __builtin_amdgcn_global_load_lds((const unsigned*)((const char*)(gbase) + (voff)[_i]), (LAS unsigned*)(lds + (bufoff) + ldsw + _i * 8192), 16, 0, 0); } while (0)
#define PG8_LDA(dst, b, h) do { _Pragma("unroll") for (int m = 0; m < 4; ++m) _Pragma("unroll") for (int k = 0; k < 2; ++k) dst[m][k] = *(const LAS bf16x8*)(lds + PG8_SA(b, h) + aoff + m * 2048 + k * 1024); } while (0)
#define PG8_LDB(dst, b, h) do { _Pragma("unroll") for (int n = 0; n < 2; ++n) _Pragma("unroll") for (int k = 0; k < 2; ++k) dst[n][k] = *(const LAS bf16x8*)(lds + PG8_SB(b, h) + boff + n * 2048 + k * 1024); } while (0)
#define PG8_MMA(ai, bj, At, Bt) do { __builtin_amdgcn_s_setprio(1); _Pragma("unroll") for (int m = 0; m < 4; ++m) _Pragma("unroll") for (int n = 0; n < 2; ++n) _Pragma("unroll") for (int k = 0; k < 2; ++k) \
        acc[ai][bj][m][n] = __builtin_amdgcn_mfma_f32_16x16x32_bf16(Bt[n][k], At[m][k], acc[ai][bj][m][n], 0, 0, 0); __builtin_amdgcn_s_setprio(0); } while (0)
#define PG8_WAIT_V(n) asm volatile("s_waitcnt vmcnt(" #n ")" ::: "memory")
#define PG8_WAIT_L(n) asm volatile("s_waitcnt lgkmcnt(" #n ")" ::: "memory")
#define PG8_BAR __builtin_amdgcn_s_barrier()
#define PG8_SCHED __builtin_amdgcn_sched_barrier(0)
    Unit cur, nxt; int ui = 0;
    if (!S.next(0, cur)) return;
    f32x4 acc[2][2][4][2];
#pragma unroll
    for (int a = 0; a < 2; ++a)
#pragma unroll
        for (int b = 0; b < 2; ++b)
#pragma unroll
            for (int m = 0; m < 4; ++m)
#pragma unroll
                for (int n = 0; n < 2; ++n) acc[a][b][m][n] = (f32x4){0.f, 0.f, 0.f, 0.f};
    bf16x8 At[4][2], B0[2][2], B1[2][2];
    const char* cA = (const char*)g.A + (size_t)cur.pm * tstepA; const char* cB = (const char*)g.Bt + (size_t)cur.pn * tstepB + (size_t)cur.pm * g.bko * 2;
    PG8_STAGE(PG8_SB(0, 0), cB, voffB); PG8_STAGE(PG8_SB(0, 1), cB + hstepB, voffB); PG8_STAGE(PG8_SA(0, 0), cA, voffA); PG8_STAGE(PG8_SA(0, 1), cA + hstepA, voffA);
    if (wr == 1) PG8_BAR;
    PG8_WAIT_V(2); PG8_BAR;
    PG8_STAGE(PG8_SB(1, 0), cB + kstep, voffB); PG8_STAGE(PG8_SA(1, 0), cA + kstep, voffA); PG8_STAGE(PG8_SB(1, 1), cB + hstepB + kstep, voffB);
    PG8_WAIT_V(6); PG8_BAR;
    for (;;) {
        const bool has_next = S.next(ui + 1, nxt);
        const char* nA = has_next ? (const char*)g.A + (size_t)nxt.pm * tstepA : cA;
        const char* nB = has_next ? (const char*)g.Bt + (size_t)nxt.pn * tstepB + (size_t)nxt.pm * g.bko * 2 : cB;
        for (int t = 0; t < nt; t += 2) {
            const bool last = (t == nt - 2);
            if constexpr (Epi::HAS_MID) { if (2 * t == nt) E.mid(acc, cur, wr, wc, fr, fq); }
            const char* a1 = cA + (size_t)(t + 1) * kstep;
            const char* a2 = last ? nA : cA + (size_t)(t + 2) * kstep; const char* b2 = last ? nB : cB + (size_t)(t + 2) * kstep;
            const char* a3 = a2 + kstep; const char* b3 = b2 + kstep;
            PG8_LDB(B0, 0, 0); PG8_LDB(B1, 0, 1); PG8_SCHED; PG8_LDA(At, 0, 0); PG8_STAGE(PG8_SA(1, 1), a1 + hstepA, voffA);
            PG8_WAIT_V(8); PG8_WAIT_L(0); PG8_BAR; PG8_MMA(0, 0, At, B0); PG8_MMA(0, 1, At, B1); PG8_BAR; PG8_SCHED;
            PG8_LDA(At, 0, 1); PG8_STAGE(PG8_SB(0, 0), b2, voffB); PG8_STAGE(PG8_SB(0, 1), b2 + hstepB, voffB); PG8_STAGE(PG8_SA(0, 0), a2, voffA);
            PG8_WAIT_V(8); PG8_WAIT_L(0); PG8_BAR; PG8_MMA(1, 0, At, B0); PG8_MMA(1, 1, At, B1); PG8_BAR; PG8_SCHED;
            PG8_LDB(B0, 1, 0); PG8_LDB(B1, 1, 1); PG8_SCHED; PG8_LDA(At, 1, 0); PG8_STAGE(PG8_SA(0, 1), a2 + hstepA, voffA);
            PG8_WAIT_V(8); PG8_WAIT_L(0); PG8_BAR; PG8_MMA(0, 0, At, B0); PG8_MMA(0, 1, At, B1); PG8_BAR; PG8_SCHED;
            PG8_LDA(At, 1, 1); PG8_STAGE(PG8_SB(1, 0), b3, voffB); PG8_STAGE(PG8_SB(1, 1), b3 + hstepB, voffB); PG8_STAGE(PG8_SA(1, 0), a3, voffA);
            PG8_WAIT_V(8); PG8_WAIT_L(0); PG8_BAR; PG8_MMA(1, 0, At, B0); PG8_MMA(1, 1, At, B1); PG8_BAR; PG8_SCHED;
        }
        if (wr == 0) PG8_BAR;
        E(acc, cur, wr, wc, fr, fq);
        if (!has_next) break;
#pragma unroll
        for (int a = 0; a < 2; ++a)
#pragma unroll
            for (int b = 0; b < 2; ++b)
#pragma unroll
                for (int m = 0; m < 4; ++m)
#pragma unroll
                    for (int n = 0; n < 2; ++n) acc[a][b][m][n] = (f32x4){0.f, 0.f, 0.f, 0.f};
        cur = nxt; cA = nA; cB = nB; ++ui;
        if (wr == 1) PG8_BAR;
    }
    PG8_WAIT_V(0);
    PG8_BAR;
#undef PG8_SA
#undef PG8_SB
#undef PG8_STAGE
#undef PG8_LDA
#undef PG8_LDB
#undef PG8_MMA
#undef PG8_WAIT_V
#undef PG8_WAIT_L
#undef PG8_BAR
#undef PG8_SCHED
}
}
namespace epi {
using pg8::Unit;
typedef f32x4 Acc[2][2][4][2];
__device__ __forceinline__ void st8(bf16_t* p, f32x4 v0, f32x4 v1) { u32x4 w; w.x = cvt_pk_bf16(v0[0], v0[1]); w.y = cvt_pk_bf16(v0[2], v0[3]); w.z = cvt_pk_bf16(v1[0], v1[1]); w.w = cvt_pk_bf16(v1[2], v1[3]); *(u32x4*)p = w; }
__device__ __forceinline__ float sq8(f32x4 a, f32x4 b) { return (a[0] * a[0] + a[1] * a[1]) + (a[2] * a[2] + a[3] * a[3]) + (b[0] * b[0] + b[1] * b[1]) + (b[2] * b[2] + b[3] * b[3]); }
typedef unsigned long long fx_t;
__device__ __forceinline__ void atomic_add_fx(fx_t* p, float v) { const long long q = __float2ll_rn(v * 1048576.0f); __hip_atomic_fetch_add(p, (fx_t)q, __ATOMIC_RELAXED, __HIP_MEMORY_SCOPE_AGENT); }
__device__ __forceinline__ float fx2f(fx_t v) { return (float)((double)(long long)v * (1.0 / 1048576.0)); }
__device__ __forceinline__ void rope8(f32x4& v0, f32x4& v1, const f32x2* rope, int pos, int i0) {
    const f32x2* t = rope + (size_t)pos * 32 + i0;
    const f32x2 a = t[0], b = t[1], c = t[2], d = t[3];
    f32x4 o0, o1;
    o0[0] = v0[0] * a.x - v0[1] * a.y; o0[1] = v0[1] * a.x + v0[0] * a.y;
    o0[2] = v0[2] * b.x - v0[3] * b.y; o0[3] = v0[3] * b.x + v0[2] * b.y;
    o1[0] = v1[0] * c.x - v1[1] * c.y; o1[1] = v1[1] * c.x + v1[0] * c.y;
    o1[2] = v1[2] * d.x - v1[3] * d.y; o1[3] = v1[3] * d.x + v1[2] * d.y;
    v0 = o0; v1 = o1;
}

struct EpiProj {
    static constexpr bool HAS_MID = false;
    bf16_t *QLAT, *KVLAT, *KR, *MQ, *MK; fx_t *ssq, *sskv; const f32x2* rope;
    __device__ __forceinline__ void operator()(const Acc& acc, const Unit& u, int wr, int wc, int fr, int fq) const {
        const int pn = u.pn, row0 = u.pm * 256 + wr * 64 + fr;
        if (pn == 5) {
            if (wc >= 2) return;
            const int col0 = wc * 32 + 8 * fq;
#pragma unroll
            for (int ai = 0; ai < 2; ++ai)
#pragma unroll
                for (int m = 0; m < 4; ++m) { const int row = row0 + ai * 128 + m * 16; f32x4 v0 = acc[ai][0][m][0], v1 = acc[ai][0][m][1];
                    rope8(v0, v1, rope, row & (SEQ - 1), col0 >> 1); st8(KR + (size_t)row * 64 + col0, v0, v1); }
            return;
        }
        bf16_t* dst; int ld, cb; fx_t* ss = nullptr;
        if (pn < 3) { dst = QLAT; ld = QR; cb = pn * 256; ss = ssq; }
        else if (pn < 5) { dst = KVLAT; ld = KVR; cb = (pn - 3) * 256; ss = sskv; }
        else if (pn < 10) { dst = MQ; ld = MW; cb = (pn - 6) * 256; }
        else { dst = MK; ld = MW; cb = (pn - 10) * 256; }
        const int col0 = cb + wc * 32 + 8 * fq;
#pragma unroll
        for (int ai = 0; ai < 2; ++ai)
#pragma unroll
            for (int m = 0; m < 4; ++m) { const int row = row0 + ai * 128 + m * 16; float s = 0.f;
#pragma unroll
                for (int bj = 0; bj < 2; ++bj) { const f32x4 v0 = acc[ai][bj][m][0], v1 = acc[ai][bj][m][1]; s += sq8(v0, v1); st8(dst + (size_t)row * ld + col0 + bj * 128, v0, v1); }
                if (ss) { s = sum_x32(sum_x16(s)); if (fq == 0) atomic_add_fx(ss + row, s); } }
    }
};
struct EpiVT {
    static constexpr bool HAS_MID = false;
    bf16_t* VT; const fx_t* ss; float inv_n;
    __device__ __forceinline__ void operator()(const Acc& acc, const Unit& u, int wr, int wc, int fr, int fq) const {
        const int f0 = u.pm * 256 + wr * 64 + fr;
#pragma unroll
        for (int bj = 0; bj < 2; ++bj) { const int tok = u.pn * 256 + bj * 128 + wc * 32 + 8 * fq; const int b = tok / SEQ, s = tok % SEQ;
            f32x4 r0 = {1.f, 1.f, 1.f, 1.f}, r1 = r0;
            if (ss) {
#pragma unroll
                for (int j = 0; j < 4; ++j) { r0[j] = 1.0f / sqrtf(fx2f(ss[tok + j]) * inv_n + EPS); r1[j] = 1.0f / sqrtf(fx2f(ss[tok + 4 + j]) * inv_n + EPS); } }
#pragma unroll
            for (int ai = 0; ai < 2; ++ai)
#pragma unroll
                for (int m = 0; m < 4; ++m) { const int f = f0 + ai * 128 + m * 16;
                    st8(VT + ((size_t)(b * 1024 + f)) * SEQ + s, acc[ai][bj][m][0] * r0, acc[ai][bj][m][1] * r1); } }
    }
};
struct EpiQ {
    static constexpr bool HAS_MID = false;
    bf16_t* Q; const fx_t* ss; const f32x2* rope;
    __device__ __forceinline__ void operator()(const Acc& acc, const Unit& u, int wr, int wc, int fr, int fq) const {
        const int row0 = u.pm * 256 + wr * 64 + fr;
#pragma unroll
        for (int ai = 0; ai < 2; ++ai)
#pragma unroll
            for (int m = 0; m < 4; ++m) { const int row = row0 + ai * 128 + m * 16; const float rs = 1.0f / sqrtf(fx2f(ss[row]) * (1.0f / QR) + EPS);
#pragma unroll
                for (int bj = 0; bj < 2; ++bj) { const int c0 = u.pn * 256 + bj * 128 + wc * 32 + 8 * fq, j0 = c0 % QKD;
                    f32x4 v0 = acc[ai][bj][m][0] * rs, v1 = acc[ai][bj][m][1] * rs;
                    if (j0 >= NOPE) rope8(v0, v1, rope, row & (SEQ - 1), (j0 - NOPE) >> 1);
                    st8(Q + (size_t)row * (NH * QKD) + c0, v0, v1); } }
    }
};
struct EpiRow {
    static constexpr bool HAS_MID = false;
    bf16_t* O; int ld; const fx_t* ss; float inv_n;
    __device__ __forceinline__ void operator()(const Acc& acc, const Unit& u, int wr, int wc, int fr, int fq) const {
        const int row0 = u.pm * 256 + wr * 64 + fr, col0 = u.pn * 256 + wc * 32 + 8 * fq;
#pragma unroll
        for (int ai = 0; ai < 2; ++ai)
#pragma unroll
            for (int m = 0; m < 4; ++m) { const int row = row0 + ai * 128 + m * 16; const float rs = ss ? 1.0f / sqrtf(fx2f(ss[row]) * inv_n + EPS) : 1.0f;
#pragma unroll
                for (int bj = 0; bj < 2; ++bj) st8(O + (size_t)row * ld + col0 + bj * 128, acc[ai][bj][m][0] * rs, acc[ai][bj][m][1] * rs); }
    }
};
struct EpiOut {
    static constexpr bool HAS_MID = true;
    bf16_t* Y; const fx_t *ssa, *ssb; fx_t* ssy;
    __device__ __forceinline__ void mid(Acc& acc, const Unit& u, int wr, int wc, int fr, int fq) const {
        int row0 = u.pm * 256 + wr * 64 + fr; asm volatile("" : "+v"(row0));
#pragma unroll
        for (int ai = 0; ai < 2; ++ai)
#pragma unroll
            for (int m = 0; m < 4; ++m) { const int row = row0 + ai * 128 + m * 16;
                const float ra = 1.0f / sqrtf(fx2f(ssa[row]) * (1.0f / MW) + EPS), rb = 1.0f / sqrtf(fx2f(ssb[row]) * (1.0f / MW) + EPS), f = ra / rb;
#pragma unroll
                for (int bj = 0; bj < 2; ++bj) { acc[ai][bj][m][0] *= f; acc[ai][bj][m][1] *= f; } }
    }
    __device__ __forceinline__ void operator()(const Acc& acc, const Unit& u, int wr, int wc, int fr, int fq) const {
        const int row0 = u.pm * 256 + wr * 64 + fr, col0 = u.pn * 256 + wc * 32 + 8 * fq;
#pragma unroll
        for (int ai = 0; ai < 2; ++ai)
#pragma unroll
            for (int m = 0; m < 4; ++m) { const int row = row0 + ai * 128 + m * 16; const float rb = 1.0f / sqrtf(fx2f(ssb[row]) * (1.0f / MW) + EPS); float s = 0.f;
#pragma unroll
                for (int bj = 0; bj < 2; ++bj) { const f32x4 v0 = acc[ai][bj][m][0] * rb, v1 = acc[ai][bj][m][1] * rb; s += sq8(v0, v1); st8(Y + (size_t)row * DM + col0 + bj * 128, v0, v1); }
                s = sum_x32(sum_x16(s)); if (fq == 0) atomic_add_fx(ssy + row, s); }
    }
};
struct EpiQPF {
    static constexpr bool HAS_MID = false;
    bf16_t* O;
    __device__ __forceinline__ void operator()(const Acc& acc, const Unit& u, int wr, int wc, int fr, int fq) const {
        const int row0 = u.pm * 256 + wr * 64 + fr, s = 2 * wc + (fq >> 1), hi = fq & 1;
#pragma unroll
        for (int ai = 0; ai < 2; ++ai)
#pragma unroll
            for (int m = 0; m < 4; ++m) { const int row = row0 + ai * 128 + m * 16;
#pragma unroll
                for (int bj = 0; bj < 2; ++bj) st8(O + ((size_t)((((row >> 5) * 8 + u.pn) * 2 + bj) * 8 + s)) * 512 + ((row & 31) + 32 * hi) * 8, acc[ai][bj][m][0], acc[ai][bj][m][1]); }
    }
};
struct EpiSc {
    static constexpr bool HAS_MID = false;
    float* SC;
    __device__ __forceinline__ void operator()(const Acc& acc, const Unit& u, int wr, int wc, int fr, int fq) const {
        const int row0 = u.pm * 256 + wr * 64 + fr, col0 = u.pn * 256 + wc * 32 + 8 * fq;
#pragma unroll
        for (int ai = 0; ai < 2; ++ai)
#pragma unroll
            for (int m = 0; m < 4; ++m) { float* p = SC + (size_t)(row0 + ai * 128 + m * 16) * NT + col0;
#pragma unroll
                for (int bj = 0; bj < 2; ++bj) { *(f32x4*)(p + bj * 128) = acc[ai][bj][m][0]; *(f32x4*)(p + bj * 128 + 4) = acc[ai][bj][m][1]; }
                __builtin_amdgcn_sched_barrier(0); }
    }
};
}
namespace attn {
struct Args {
    const bf16_t *Qm, *Km, *KR, *VmT;
    const bf16_t *MQ, *MK, *MVT, *KMEAN;
    const float* KMAX;
    unsigned* SELM;
    unsigned short* LIST; int* CNT;
    float* QN;
    bf16_t* PO; f32x2* PML;
    bf16_t* O;
    epi::fx_t *ssa, *ssb;
};
__device__ __forceinline__ f32x16 mfma32(bf16x8 a, bf16x8 b, f32x16 c) { return __builtin_amdgcn_mfma_f32_32x32x16_bf16(a, b, c, 0, 0, 0); }
__device__ __forceinline__ bf16x8 pack8(const f32x16& p, int b0) {
    u32x4 w; w.x = cvt_pk_bf16(p[b0 + 0], p[b0 + 1]); w.y = cvt_pk_bf16(p[b0 + 2], p[b0 + 3]); w.z = cvt_pk_bf16(p[b0 + 4], p[b0 + 5]); w.w = cvt_pk_bf16(p[b0 + 6], p[b0 + 7]);
    return __builtin_bit_cast(bf16x8, w);
}
__device__ __forceinline__ float xhalf_max(float v) { const auto r = __builtin_amdgcn_permlane32_swap(__float_as_uint(v), __float_as_uint(v), false, false); return fmaxf(__uint_as_float(r[0]), __uint_as_float(r[1])); }

template <int DK, int MODE>
__device__ __forceinline__ void attn_block(LAS unsigned char* lds, const Args& A, int b, int h, int qb, int chunk = 0, int cnt = 0) {
    constexpr bool MOBA = MODE != 0;
    constexpr int KST = DK * 2 + 16, VST = 144, KBUF = 64 * KST, VBUF = 128 * VST, SET = KBUF + VBUF, NS = DK / 16;
    static_assert(2 * SET <= 131072, "attention LDS map");
    int tid = threadIdx.x; asm volatile("" : "+v"(tid));
    const int wid = __builtin_amdgcn_readfirstlane(tid >> 6), lane = tid & 63, r32 = lane & 31, hi = lane >> 5;
    const size_t tokb = (size_t)b * SEQ;
    int q0 = qb * 256, qw0 = q0 + wid * 32, qpos = qw0 + r32; bool qvalid = true;
    if constexpr (MODE == 2) {
        const int li = chunk * 256 + wid * 32 + r32; qvalid = li < cnt;
        qpos = A.LIST[(size_t)((b * NH + h) * 32 + qb) * SEQ + (qvalid ? li : 0)]; q0 = 0; qw0 = 1 << 20; }
    const float NEG = -__builtin_inff();
    bf16x8 qr[NS];
    { const bf16_t* qp = MOBA ? A.MQ + (tokb + qpos) * MW + h * 128 + hi * 8 : A.Qm + (tokb + qpos) * (NH * QKD) + h * QKD + hi * 8;
#pragma unroll
      for (int s = 0; s < NS; ++s) qr[s] = *(const bf16x8*)(qp + 16 * s); }
    if constexpr (!MOBA) {
        constexpr float QS = 0.07216878364870322f * 1.4426950408889634f;
#pragma unroll
        for (int s = 0; s < NS; ++s) { const u32x4 w = __builtin_bit_cast(u32x4, qr[s]); u32x4 v;
            v.x = cvt_pk_bf16(bf_lo(w.x) * QS, bf_hi(w.x) * QS); v.y = cvt_pk_bf16(bf_lo(w.y) * QS, bf_hi(w.y) * QS); v.z = cvt_pk_bf16(bf_lo(w.z) * QS, bf_hi(w.z) * QS); v.w = cvt_pk_bf16(bf_lo(w.w) * QS, bf_hi(w.w) * QS);
            qr[s] = __builtin_bit_cast(bf16x8, v); } }
    const bf16_t* baseN = (MOBA ? A.MK : A.Km) + tokb * 1024 + h * 128;
    const bf16_t* baseR = A.KR + tokb * ROPE;
    const bf16_t* baseV = (MOBA ? A.MVT : A.VmT) + ((size_t)(b * 1024 + h * 128)) * SEQ;
    const unsigned offN = (unsigned)((tid >> 4) * 1024 + 8 * (tid & 15)), offR = (unsigned)tid * 8u, offV = (unsigned)((tid >> 3) * SEQ + 8 * (tid & 7));
    const int dstN = (tid >> 4) * KST + (tid & 15) * 16, dstR = (tid >> 3) * KST + 256 + (tid & 7) * 16, dstV = (tid >> 3) * VST + (tid & 7) * 16;
    const int pr = (r32 & ~0xC) | ((r32 & 4) << 1) | ((r32 & 8) >> 1);
    const int koff = pr * KST + hi * 16, voff = r32 * VST + hi * 16;
    const int ntile = 4 * (qb + 1);
    constexpr float LOG2E = 1.4426950408889634f;
    const float c2 = (MOBA ? 0.08838834764831845f : 0.07216878364870322f) * LOG2E;
    const float sl2 = MOBA ? __builtin_amdgcn_exp2f(-(float)(h + 1)) * LOG2E : 0.f;
    unsigned sel = 0u;
    if constexpr (MOBA) sel = A.SELM[(size_t)(b * NH + h) * SEQ + qpos];
    bool wskip = false;
    if constexpr (MODE == 2) wskip = !__any(qvalid);
    float m = MOBA ? -1e30f : 0.f, l = 0.f;
    f32x16 cinit = {};
    f32x16 o[4];
#pragma unroll
    for (int d = 0; d < 4; ++d) o[d] = (f32x16){};
    if constexpr (MODE == 3) {
        const int nsel = __builtin_popcount(sel); const size_t pbase = ((size_t)(b * NH + h) * SEQ + qpos) * 3;
        float mi[3], li[3];
#pragma unroll
        for (int i = 0; i < 3; ++i) { const f32x2 ml = (i < nsel) ? A.PML[pbase + i] : (f32x2){-1e30f, 0.f}; mi[i] = ml.x; li[i] = ml.y; }
        m = fmaxf(mi[0], fmaxf(mi[1], mi[2]));
        float lsum = 0.f;
#pragma unroll
        for (int i = 0; i < 3; ++i) { const float w = li[i] * __builtin_amdgcn_exp2f(mi[i] - m); lsum += w;
            if (__any(i < nsel && li[i] > 0.f)) { const bf16_t* pp = A.PO + (pbase + i) * 128 + 4 * hi; const bool have = i < nsel && li[i] > 0.f; const float wv = have ? w : 0.f;
#pragma unroll
                for (int d = 0; d < 4; ++d)
#pragma unroll
                    for (int g = 0; g < 4; ++g) { const u32x2 pw = have ? *(const u32x2*)(pp + 32 * d + 8 * g) : (u32x2){0u, 0u};
                        o[d][4 * g] = fmaf(wv, bf_lo(pw.x), o[d][4 * g]); o[d][4 * g + 1] = fmaf(wv, bf_hi(pw.x), o[d][4 * g + 1]); o[d][4 * g + 2] = fmaf(wv, bf_lo(pw.y), o[d][4 * g + 2]); o[d][4 * g + 3] = fmaf(wv, bf_hi(pw.y), o[d][4 * g + 3]); } } }
        l = hi == 0 ? lsum : 0.f;
    }
#pragma unroll
    for (int s = 0; s < NS; ++s) asm volatile("" : "+v"(qr[s]));
    u32x4 sk[3], sv[2];
#define AT_LOAD(kb_) do { const bf16_t* n_ = baseN + (size_t)(kb_) * 1024; sk[0] = *(const u32x4*)(n_ + offN); sk[1] = *(const u32x4*)(n_ + 32 * 1024 + offN); \
                          if constexpr (!MOBA) sk[2] = *(const u32x4*)(baseR + (size_t)(kb_) * ROPE + offR); \
                          const bf16_t* v_ = baseV + (kb_); sv[0] = *(const u32x4*)(v_ + offV); sv[1] = *(const u32x4*)(v_ + (size_t)64 * SEQ + offV); } while (0)
#define AT_WRITE(bf_) do { LAS unsigned char* kb__ = lds + (bf_) * SET; *(LAS u32x4*)(kb__ + dstN) = sk[0]; *(LAS u32x4*)(kb__ + 32 * KST + dstN) = sk[1]; \
                           if constexpr (!MOBA) *(LAS u32x4*)(kb__ + dstR) = sk[2]; \
                           *(LAS u32x4*)(kb__ + KBUF + dstV) = sv[0]; *(LAS u32x4*)(kb__ + KBUF + 64 * VST + dstV) = sv[1]; } while (0)
    auto next_t = [&](int t_) { return t_ + 1; };
    int t = MOBA ? 4 * qb : 0, cb = 0;
    AT_LOAD(t * 64); AT_WRITE(0); __syncthreads();
    for (; t < ntile; ) {
        const int tn = next_t(t);
        const int kb = t * 64;
        LAS unsigned char* Kb = lds + cb * SET; LAS unsigned char* Vb = Kb + KBUF;
        if (tn < ntile) AT_LOAD(tn * 64);
        bool act = kb <= qw0 + 31;
        if constexpr (MODE == 2) act = !wskip;
        if (act) {
            f32x16 p0 = cinit, p1 = cinit;
            bf16x8 ka[3][2];
#define KRD(s_) do { ka[(s_) % 3][0] = *(const LAS bf16x8*)(Kb + koff + (s_) * 32); ka[(s_) % 3][1] = *(const LAS bf16x8*)(Kb + koff + 32 * KST + (s_) * 32); } while (0)
            KRD(0); KRD(1);
#pragma unroll
            for (int s = 0; s < NS; ++s) {
                if (s + 2 < NS) KRD(s + 2);
                p0 = mfma32(ka[s % 3][0], qr[s], p0); p1 = mfma32(ka[s % 3][1], qr[s], p1);
                __builtin_amdgcn_sched_barrier(0); }
#undef KRD
            if constexpr (MOBA) {
                const float base0 = sl2 * (float)(kb - qpos + 8 * hi), base1 = base0 + 32.f * sl2;
#pragma unroll
                for (int r = 0; r < 16; ++r) { const float kc = (float)((r & 7) + 16 * (r >> 3));
                    p0[r] = fmaf(kc, sl2, fmaf(p0[r], c2, base0)); p1[r] = fmaf(kc, sl2, fmaf(p1[r], c2, base1)); }
            }
            if (kb + 63 > qw0) {
                const int dq = qpos - kb - 8 * hi;
#pragma unroll
                for (int r = 0; r < 16; ++r) { const int kc = (r & 7) + 16 * (r >> 3); if (kc > dq) p0[r] = NEG; if (kc + 32 > dq) p1[r] = NEG; }
            }
            float mx = fmaxf(p0[0], p1[0]);
#pragma unroll
            for (int r = 1; r < 16; ++r) asm("v_max3_f32 %0, %1, %2, %3" : "=v"(mx) : "v"(mx), "v"(p0[r]), "v"(p1[r]));
            mx = xhalf_max(mx);
            if constexpr (MOBA) {
                if (!__all(mx <= m + 11.5f)) {
                    const float mn = fmaxf(m, mx);
                    const float al = __builtin_amdgcn_exp2f(m - mn);
                    m = mn; l *= al;
#pragma unroll
                    for (int d = 0; d < 4; ++d)
#pragma unroll
                        for (int r = 0; r < 16; ++r) o[d][r] *= al;
                }
            } else {
                if (t == 0 || !__all(mx <= 11.5f)) {
                    const float dm = t == 0 ? mx : fmaxf(mx, 0.f);
                    const float al = t == 0 ? 0.f : __builtin_amdgcn_exp2f(-dm);
                    m += dm; l *= al;
#pragma unroll
                    for (int d = 0; d < 4; ++d)
#pragma unroll
                        for (int r = 0; r < 16; ++r) o[d][r] *= al;
#pragma unroll
                    for (int r = 0; r < 16; ++r) { p0[r] -= dm; p1[r] -= dm; cinit[r] = -m; }
                    asm volatile("" : "+v"(cinit));
                }
            }
            float ps = 0.f, sa = 0.f, sb = 0.f, sc = 0.f, sd = 0.f;
#define ADD4(r_) do { if ((r_) & 1) { asm("v_add_f32 %0, %0, %1" : "+v"(sc) : "v"(p0[r_])); asm("v_add_f32 %0, %0, %1" : "+v"(sd) : "v"(p1[r_])); } \
                      else { asm("v_add_f32 %0, %0, %1" : "+v"(sa) : "v"(p0[r_])); asm("v_add_f32 %0, %0, %1" : "+v"(sb) : "v"(p1[r_])); } } while (0)
            if constexpr (MOBA) {
#pragma unroll
                for (int r = 0; r < 16; ++r) { p0[r] = __builtin_amdgcn_exp2f(p0[r] - m); p1[r] = __builtin_amdgcn_exp2f(p1[r] - m); ADD4(r); }
            } else {
#pragma unroll
                for (int r = 0; r < 16; ++r) { p0[r] = __builtin_amdgcn_exp2f(p0[r]); p1[r] = __builtin_amdgcn_exp2f(p1[r]); ADD4(r); }
            }
#undef ADD4
            ps = (sa + sb) + (sc + sd);
            l += ps;
            bf16x8 pb[4]; pb[0] = pack8(p0, 0); pb[1] = pack8(p0, 8); pb[2] = pack8(p1, 0); pb[3] = pack8(p1, 8);
            bf16x8 vr[4];
#pragma unroll
            for (int s2 = 0; s2 < 4; ++s2) vr[s2] = *(const LAS bf16x8*)(Vb + voff + 2 * 32 * VST + s2 * 32);
#pragma unroll
            for (int d = 0; d < 2; ++d)
#pragma unroll
                for (int s2 = 0; s2 < 4; ++s2) { o[d] = mfma32(*(const LAS bf16x8*)(Vb + voff + d * 32 * VST + s2 * 32), pb[s2], o[d]); if (s2 == 3 && (d & 1)) __builtin_amdgcn_sched_barrier(0); }
#pragma unroll
            for (int s2 = 0; s2 < 4; ++s2) { o[2] = mfma32(vr[s2], pb[s2], o[2]); vr[s2] = *(const LAS bf16x8*)(Vb + voff + 3 * 32 * VST + s2 * 32); __builtin_amdgcn_sched_barrier(0); }
#pragma unroll
            for (int s2 = 0; s2 < 4; ++s2) o[3] = mfma32(vr[s2], pb[s2], o[3]);
            __builtin_amdgcn_sched_barrier(0);
        }
        if (tn < ntile) AT_WRITE(cb ^ 1);
        __syncthreads();
        t = tn; cb ^= 1;
    }
#undef AT_LOAD
#undef AT_WRITE
    l = sum_x32(l);
    const float inv = l > 0.f ? 1.0f / l : 0.f;
    float ss = 0.f; u32x4 st[8];
#pragma unroll
    for (int d = 0; d < 4; ++d)
#pragma unroll
        for (int g = 0; g < 4; g += 2) { u32x2 wa, wb;
            { const float a0 = o[d][4 * g] * inv, a1 = o[d][4 * g + 1] * inv, a2 = o[d][4 * g + 2] * inv, a3 = o[d][4 * g + 3] * inv; ss += (a0 * a0 + a1 * a1) + (a2 * a2 + a3 * a3); wa.x = cvt_pk_bf16(a0, a1); wa.y = cvt_pk_bf16(a2, a3); }
            { const float a0 = o[d][4 * g + 4] * inv, a1 = o[d][4 * g + 5] * inv, a2 = o[d][4 * g + 6] * inv, a3 = o[d][4 * g + 7] * inv; ss += (a0 * a0 + a1 * a1) + (a2 * a2 + a3 * a3); wb.x = cvt_pk_bf16(a0, a1); wb.y = cvt_pk_bf16(a2, a3); }
            const auto rx = __builtin_amdgcn_permlane32_swap(wa.x, wb.x, false, false), ry = __builtin_amdgcn_permlane32_swap(wa.y, wb.y, false, false);
            st[2 * d + (g >> 1)] = (u32x4){rx[0], ry[0], rx[1], ry[1]}; }
    if constexpr (MODE == 2) {
        if (qvalid) { const int slot = __builtin_popcount(sel & ((1u << qb) - 1u)); const size_t pidx = ((size_t)(b * NH + h) * SEQ + qpos) * 3 + slot;
            if (hi == 0) A.PML[pidx] = (f32x2){m, l};
            bf16_t* pp = A.PO + pidx * 128 + 8 * hi;
#pragma unroll
            for (int k2 = 0; k2 < 8; ++k2) *(u32x4*)(pp + 16 * k2) = st[k2]; }
    } else {
    bf16_t* op = A.O + (tokb + qpos) * DM + (MOBA ? MW : 0) + h * 128 + 8 * hi;
#pragma unroll
    for (int k2 = 0; k2 < 8; ++k2) *(u32x4*)(op + 16 * k2) = st[k2];
    ss = sum_x32(ss);
    if (hi == 0) epi::atomic_add_fx((MOBA ? A.ssb : A.ssa) + tokb + qpos, ss);
    }
}

__device__ __forceinline__ void moba_gate_phase(const Args& A, int gw, int ngw) {
    int tid = threadIdx.x; asm volatile("" : "+v"(tid));
    const int lane = tid & 63, r32 = lane & 31, hi = lane >> 5;
    const float NEG = -__builtin_inff();
    for (int it = gw; it < NB * NH * (SEQ / 32); it += ngw) { const int qt = it & 255, bh = it >> 8, b = bh >> 3, h = bh & 7, qpos = qt * 32 + r32, qb = qt >> 3;
        unsigned sel = 0u;
        bf16x8 qr[8];
        { const bf16_t* qp = A.MQ + ((size_t)b * SEQ + qpos) * MW + h * 128 + hi * 8;
#pragma unroll
          for (int s = 0; s < 8; ++s) qr[s] = *(const bf16x8*)(qp + 16 * s); }
        float q2 = 0.f;
#pragma unroll
        for (int s = 0; s < 8; ++s) { const u32x4 w = __builtin_bit_cast(u32x4, qr[s]);
#pragma unroll
            for (int c = 0; c < 4; ++c) { const float a = bf_lo(w[c]), bb = bf_hi(w[c]); q2 += a * a + bb * bb; } }
        q2 += __shfl_xor(q2, 32);
        if (qb > 0) {
            const bf16_t* kmp = A.KMEAN + ((size_t)((b * NH + h) * 32 + r32)) * 128 + hi * 8;
            f32x16 g = {};
#pragma unroll
            for (int s = 0; s < 8; ++s) g = mfma32(*(const bf16x8*)(kmp + 16 * s), qr[s], g);
            float v1 = NEG, v2 = NEG, v3 = NEG; int i1 = 0, i2 = 0, i3 = 0;
#pragma unroll
            for (int r = 0; r < 16; ++r) { const int j = (r & 3) + 8 * (r >> 2) + 4 * hi; const float x = (j < qb) ? g[r] : NEG;
                if (x > v1) { v3 = v2; i3 = i2; v2 = v1; i2 = i1; v1 = x; i1 = j; } else if (x > v2) { v3 = v2; i3 = i2; v2 = x; i2 = j; } else if (x > v3) { v3 = x; i3 = j; } }
            float pv[3]; int pi[3];
            pv[0] = __shfl_xor(v1, 32); pv[1] = __shfl_xor(v2, 32); pv[2] = __shfl_xor(v3, 32); pi[0] = __shfl_xor(i1, 32); pi[1] = __shfl_xor(i2, 32); pi[2] = __shfl_xor(i3, 32);
#pragma unroll
            for (int k = 0; k < 3; ++k) { const float x = pv[k]; const int j = pi[k];
                if (x > v1 || (x == v1 && j < i1)) { v3 = v2; i3 = i2; v2 = v1; i2 = i1; v1 = x; i1 = j; }
                else if (x > v2 || (x == v2 && j < i2)) { v3 = v2; i3 = i2; v2 = x; i2 = j; }
                else if (x > v3 || (x == v3 && j < i3)) { v3 = x; i3 = j; } }
            sel = (v1 > NEG ? 1u << i1 : 0u) | (v2 > NEG ? 1u << i2 : 0u) | (v3 > NEG ? 1u << i3 : 0u);
        }
        if (hi == 0) { const size_t qi = (size_t)bh * SEQ + qpos; A.SELM[qi] = sel; A.QN[qi] = sqrtf(q2) * 1.001f;
            A.PML[qi * 3] = (f32x2){-1e30f, 0.f}; A.PML[qi * 3 + 1] = (f32x2){-1e30f, 0.f}; A.PML[qi * 3 + 2] = (f32x2){-1e30f, 0.f}; }
    }
}

__device__ __forceinline__ void moba_list_phase(const Args& A, int gw, int ngw) {
    int tid = threadIdx.x; asm volatile("" : "+v"(tid));
    const int lane = tid & 63;
    constexpr float LOG2E = 1.4426950408889634f; const float c2 = 0.08838834764831845f * LOG2E;
    for (int it = gw; it < NB * NH * 32; it += ngw) { const int j = it & 31, bh = it >> 5, h = bh & 7; int n = 0;
        const float sl2 = __builtin_amdgcn_exp2f(-(float)(h + 1)) * LOG2E, kj = A.KMAX[bh * 32 + j];
        unsigned short* lst = A.LIST + (size_t)it * SEQ;
        for (int s0 = 256 * (j + 1); s0 < SEQ; s0 += 256) {
            unsigned sm[4]; float qn[4];
#pragma unroll
            for (int u = 0; u < 4; ++u) { sm[u] = A.SELM[(size_t)bh * SEQ + s0 + 64 * u + lane]; qn[u] = A.QN[(size_t)bh * SEQ + s0 + 64 * u + lane]; }
            const float ksum = kj + A.KMAX[bh * 32 + (s0 >> 8)];
#pragma unroll
            for (int u = 0; u < 4; ++u) { const int s = s0 + 64 * u + lane;
                bool on = (sm[u] >> j) & 1u;
                if (on) { const float bound = qn[u] * ksum * c2 - sl2 * (float)(s - (256 * (j + 1) - 1)); if (bound < -150.f) on = false; }
                const unsigned long long bal = __ballot(on);
                if (on) lst[n + __builtin_popcountll(bal & ((1ull << lane) - 1ull))] = (unsigned short)s;
                n += __builtin_popcountll(bal); } }
        if (lane == 0) A.CNT[it] = n; }
}
__device__ __forceinline__ void moba_routed_phase(LAS unsigned char* lds, const Args& A, int vcu, int G) {
    LAS int* pre = (LAS int*)(lds + 120 * 1024);
    { int tid = threadIdx.x; asm volatile("" : "+v"(tid));
      if (tid < 64) { int v[16], s = 0;
#pragma unroll
          for (int i = 0; i < 16; ++i) { v[i] = (A.CNT[tid * 16 + i] + 255) >> 8; s += v[i]; }
          int inc = s;
#pragma unroll
          for (int o_ = 1; o_ < 64; o_ <<= 1) { const int t_ = __shfl_up(inc, o_); if (tid >= o_) inc += t_; }
          int run = inc - s;
#pragma unroll
          for (int i = 0; i < 16; ++i) { pre[tid * 16 + i] = run; run += v[i]; }
          if (tid == 63) pre[1024] = run; }
      __syncthreads(); }
    const int total = pre[1024];
    for (int u = vcu; u < total; u += G) {
        int lo_ = 0, hi_ = 1024;
        while (hi_ - lo_ > 1) { const int mid = (lo_ + hi_) >> 1; if (pre[mid] <= u) lo_ = mid; else hi_ = mid; }
        const int it = lo_, j = it & 31, bh = it >> 5;
        attn_block<128, 2>(lds, A, bh >> 3, bh & 7, j, u - pre[it], A.CNT[it]);
    }
    __syncthreads();
}
__device__ __forceinline__ void mla_phase(LAS unsigned char* lds, const Args& A, int vcu, int G) {
    for (int it = vcu; it < 512; it += G) { const int bh = it >> 4, x = it & 15, b = bh >> 3, h = bh & 7;
        for (int pass = 0; pass < 2; ++pass) attn_block<QKD, 0>(lds, A, b, h, pass ? x : 31 - x); }
}
__device__ __forceinline__ void moba_own_phase(LAS unsigned char* lds, const Args& A, int vcu, int G) {
    for (int it = vcu; it < NB * NH * 32; it += G) attn_block<128, 3>(lds, A, it >> 8, (it >> 5) & 7, it & 31);
}
}
constexpr size_t MiB = 1u << 20;
constexpr size_t WS_CTL = 0, CTL_ZERO_BYTES = 2 * MiB;
constexpr size_t WS_ROPE = 2 * MiB;
constexpr size_t WS_KMEAN = 4 * MiB;
constexpr size_t WS_KMAX = 4 * MiB + 512 * 1024;
constexpr size_t WS_QN = 15 * MiB;
constexpr size_t WS_CNT = 7 * MiB;
constexpr size_t WS_PML = 8 * MiB;
constexpr size_t WS_LIST = 368 * MiB;
constexpr size_t WS_PO = 176 * MiB;
constexpr size_t WS_SELM = 6 * MiB;
constexpr size_t WS_W_IN = 6 * MiB;
constexpr size_t WS_W_UQ = 24 * MiB;
constexpr size_t WS_W_UKV = 27 * MiB;
constexpr size_t WS_W_OUT = 29 * MiB;
constexpr size_t WS_W_PQ = 37 * MiB;
constexpr size_t WS_W_SK = 45 * MiB;
constexpr size_t WS_U = 48 * MiB, WS_V = 112 * MiB;
constexpr size_t WS_US = 46 * MiB, WS_VS = 47 * MiB;
constexpr size_t WS_UP = 820 * MiB;
constexpr size_t WS_T8 = 804 * MiB, WS_S0 = 818 * MiB;
constexpr size_t WS_H8 = 836 * MiB, WS_HS = 900 * MiB;
constexpr size_t WS_X1B = 432 * MiB;
constexpr size_t WS_PD = 304 * MiB;
constexpr size_t WS_DOT = 804 * MiB;
constexpr size_t WS_Y2 = 304 * MiB;
constexpr size_t WS_H = 176 * MiB;
constexpr size_t WS_QLAT = 304 * MiB, WS_KVLAT = 352 * MiB, WS_KR = 384 * MiB, WS_MQ = 388 * MiB, WS_MK = 452 * MiB, WS_MVT = 516 * MiB;
constexpr size_t WS_QM = 580 * MiB, WS_KM = 676 * MiB, WS_VMT = 740 * MiB;
constexpr size_t WS_O = 804 * MiB;
constexpr size_t WS_IDS = 932 * MiB, WS_G = 948 * MiB, WS_MODP = 964 * MiB, WS_END = 972 * MiB;
constexpr size_t WS_MOD = 5 * MiB;
constexpr size_t WS_PRM = 5 * MiB + 256 * 1024;
constexpr size_t WS_Y = WS_QLAT;
constexpr size_t WS_QP = WS_QM;
constexpr size_t WS_SC = WS_QLAT;
static_assert(WS_SC + (size_t)2048 * NT * 4 <= WS_QM && WS_QP + (size_t)NT * DM * 2 <= WS_O, "d_ws overlays");
constexpr int CW_BAR = 1024;
constexpr int CW_XRANK = 6144;
constexpr int CW_SSQ = 8192, CW_SSKV = CW_SSQ + 2 * NT, CW_SSA = CW_SSKV + 2 * NT, CW_SSB = CW_SSA + 2 * NT, CW_SSY = CW_SSB + 2 * NT, CW_SSY2 = CW_SSY + 2 * NT;
static_assert((size_t)(CW_SSY2 + 2 * NT) * 4 <= CTL_ZERO_BYTES, "CTL words inside the memset region");
#define CTL_FX(w) ((epi::fx_t*)(F.ctlf + (w)))

constexpr int NWAVES = 8;
constexpr int RING_BYTES = 131072, LDSCTL_OFF = RING_BYTES, LDS_BYTES = 147456;

#define XB_TMO      128
#define XB_XCNT(j)  (256  + 64 * (j))
#define XB_XSUB(j)  (1280 + 64 * (j))
#define XB_XGEN(j)  (2304 + 64 * (j))
#define XB_TOP      3328
#define XB_TOPGEN   3392
#define XCD_BAR_WORDS 3456
#define XB_SPIN_CAP (1u << 24)
__device__ __forceinline__ unsigned xb_ld(unsigned* p)              { return __hip_atomic_load(p, __ATOMIC_RELAXED, __HIP_MEMORY_SCOPE_AGENT); }
__device__ __forceinline__ unsigned xb_add(unsigned* p, unsigned v) { return __hip_atomic_fetch_add(p, v, __ATOMIC_RELAXED, __HIP_MEMORY_SCOPE_AGENT); }
__device__ __forceinline__ unsigned xb_xcc_id() { return (unsigned)__builtin_amdgcn_s_getreg((3 << 11) | 20) & 0xFu; }
#define XB_SPIN(cond, bar) do { unsigned _sp = 0; while (cond) { __builtin_amdgcn_s_sleep(1); \
    if ((++_sp & 255u) == 0u) { if (xb_ld(&(bar)[XB_TMO])) break; if (_sp > XB_SPIN_CAP) { atomicAdd(&(bar)[XB_TMO], 1u); break; } } } } while (0)
struct XcdBarrier { unsigned* bar; unsigned x; volatile LAS unsigned* st; };
__device__ __forceinline__ XcdBarrier xcd_barrier_post(unsigned* bar, volatile LAS unsigned* st) {
    XcdBarrier b; b.bar = bar; b.x = xb_xcc_id(); b.st = st;
    if (threadIdx.x == 0) (void)xb_add(&bar[XB_XCNT(b.x)], 1u);
    return b;
}
__device__ __forceinline__ void xcd_barrier_complete(unsigned* bar, unsigned x, unsigned& nloc, unsigned& nx) {
    const unsigned G = gridDim.x * gridDim.y * gridDim.z;
    unsigned sum, cnt, mine, sp = 0u;
    for (;;) {
        sum = 0u; cnt = 0u; mine = 0u;
#pragma unroll
        for (unsigned j = 0; j < 16; ++j) { const unsigned c = xb_ld(&bar[XB_XCNT(j)]); sum += c; cnt += (c > 0u) ? 1u : 0u; mine = (j == x) ? c : mine; }
        if (sum == G) break;
        __builtin_amdgcn_s_sleep(1);
        if ((++sp & 255u) == 0u) { if (xb_ld(&bar[XB_TMO])) break; if (sp > XB_SPIN_CAP) { atomicAdd(&bar[XB_TMO], 1u); break; } }
    }
    nloc = mine > 0u ? mine : 1u; nx = cnt > 0u ? cnt : 1u;
}
__device__ __forceinline__ void xcd_barrier(const XcdBarrier& b) {
    asm volatile("s_waitcnt vmcnt(0)" ::: "memory");
    __syncthreads();
    if (threadIdx.x == 0) {
        unsigned* bar = b.bar;
        __builtin_amdgcn_s_waitcnt(0);
        unsigned nloc = b.st[0], nx = b.st[1];
        if (nloc == 0u) { xcd_barrier_complete(bar, b.x, nloc, nx); b.st[0] = nloc; b.st[1] = nx; }
        const unsigned old = xb_add(&bar[XB_XSUB(b.x)], 1u);
        const unsigned gen = old / nloc;
        if (old + 1u == (gen + 1u) * nloc) {
            __builtin_amdgcn_fence(__ATOMIC_RELEASE, "agent");
            asm volatile("s_waitcnt vmcnt(0)" ::: "memory");
            const unsigned og = xb_add(&bar[XB_TOP], 1u);
            const unsigned tg = og / nx;
            if (og + 1u == (tg + 1u) * nx) xb_add(&bar[XB_TOPGEN], 1u);
            else XB_SPIN(xb_ld(&bar[XB_TOPGEN]) == tg, bar);
            __builtin_amdgcn_fence(__ATOMIC_ACQUIRE, "agent");
            xb_add(&bar[XB_XGEN(b.x)], 1u);
            asm volatile("s_waitcnt vmcnt(0)" ::: "memory");
        } else {
            XB_SPIN(xb_ld(&bar[XB_XGEN(b.x)]) == gen, bar);
            __builtin_amdgcn_fence(__ATOMIC_ACQUIRE, "agent");
            asm volatile("s_waitcnt vmcnt(0)" ::: "memory");
        }
    }
    __syncthreads();
}

struct Args { const float* in[21]; float* out; unsigned char* ws; int ph_lo, ph_hi; };
struct Frame {
    LAS unsigned char* lds;
    int vcu, G;
    int xrank, xidx, xn, xloc;
    const struct Args* a; float* out; unsigned char* ws;
    float* ctlf;
};
#define WSP(T, off) ((T*)(F.ws + (off)))
#define LDS_WAIT() asm volatile("s_waitcnt lgkmcnt(0)" ::: "memory")
#define PHASE_TID() int tid_ = threadIdx.x; asm volatile("" : "+v"(tid_)); const int lane = tid_ & 63, wave = __builtin_amdgcn_readfirstlane(tid_ >> 6); (void)lane; (void)wave

__device__ __forceinline__ void tr_item(const float* W, int K, int N, bf16_t* WT, int k0, int n0, int dbase, int dstride, const float* gk, LAS float* scr, int lane) {
#pragma unroll 8
    for (int i = 0; i < 32; ++i) { const int kk = 2 * i + (lane >> 5); float w = W[(size_t)(k0 + kk) * N + n0 + (lane & 31)]; if (gk) w *= gk[kk]; scr[kk * 33 + (lane & 31)] = w; }
    LDS_WAIT(); asm volatile("" ::: "memory");
    const int c = lane & 7;
#pragma unroll
    for (int j = 0; j < 4; ++j) { const int n = (lane >> 3) + 8 * j; const LAS float* s = scr + (8 * c) * 33 + n;
        u32x4 o; o.x = cvt_pk_bf16(s[0 * 33], s[1 * 33]); o.y = cvt_pk_bf16(s[2 * 33], s[3 * 33]); o.z = cvt_pk_bf16(s[4 * 33], s[5 * 33]); o.w = cvt_pk_bf16(s[6 * 33], s[7 * 33]);
        *(u32x4*)(WT + (size_t)(dbase + dstride * n) * K + k0 + 8 * c) = o; }
    LDS_WAIT(); asm volatile("" ::: "memory");
}
__device__ __forceinline__ float silu(float v) { return v / (1.0f + __expf(-v)); }

__device__ __forceinline__ void p0_prologue(Frame& F) {
    PHASE_TID();
    const int gw = F.vcu * NWAVES + wave, NGW = F.G * NWAVES;
    { const float* c = F.a->in[1]; const float* w = F.a->in[2]; float* modp = WSP(float, WS_MODP);
      for (int it = gw; it < 48 * 32; it += NGW) { const int cb = it % 48, kb = it / 48, n = cb * 256 + lane * 4;
          f32x4 acc[4];
#pragma unroll
          for (int b = 0; b < 4; ++b) acc[b] = (f32x4){0.f, 0.f, 0.f, 0.f};
#pragma unroll 4
          for (int kk = 0; kk < 64; ++kk) { const int k = kb * 64 + kk; const f32x4 wv = *(const f32x4*)(w + (size_t)k * (6 * DM) + n);
#pragma unroll
              for (int b = 0; b < 4; ++b) acc[b] += wv * silu(c[b * DM + k]); }
#pragma unroll
          for (int b = 0; b < 4; ++b) *(f32x4*)(modp + ((size_t)kb * 4 + b) * (6 * DM) + n) = acc[b]; } }
}
__device__ __forceinline__ void p0_mod_reduce(Frame& F) {
    PHASE_TID();
    const int gt = (F.vcu * NWAVES + wave) * 64 + lane, NGT = F.G * NWAVES * 64;
    const float* modp = WSP(float, WS_MODP); float* mod = WSP(float, WS_MOD); const float* bias = F.a->in[3];
    for (int i = gt; i < 4 * 6 * DM; i += NGT) { float s = bias[i % (6 * DM)];
#pragma unroll 8
        for (int kb = 0; kb < 32; ++kb) s += modp[(size_t)kb * (4 * 6 * DM) + i];
        mod[i] = s;
        { const int b = i / (6 * DM), r = i % (6 * DM), v = r / DM, c = r % DM; float* prm = WSP(float, WS_PRM) + (size_t)b * (4 * DM) + c;
          if (v == 1) prm[0] = F.a->in[4][c] * (1.0f + s); else if (v == 2) prm[DM] = s * F.a->in[13][c]; else if (v == 4) prm[2 * DM] = F.a->in[14][c] * (1.0f + s); else if (v == 5) prm[3 * DM] = s * F.a->in[20][c]; } }
}
__device__ __forceinline__ unsigned pack_i8(f32x4 x) {
    const int a = __float2int_rn(x[0]), b = __float2int_rn(x[1]), c = __float2int_rn(x[2]), d = __float2int_rn(x[3]);
    return ((unsigned)a & 255u) | (((unsigned)b & 255u) << 8) | (((unsigned)c & 255u) << 16) | ((unsigned)d << 24); }
__device__ __forceinline__ void p0_convert(Frame& F) {
    PHASE_TID();
    LAS float* scr = (LAS float*)(F.lds + wave * 16384);
    const int gw = F.vcu * NWAVES + wave, NGW = F.G * NWAVES;
    const int gt = gw * 64 + lane, NGT = NGW * 64;
    { constexpr int I_IN = 32 * 138, I_UQ = 12 * 48, I_UKV = 8 * 64, I_OUT = 32 * 64, I_PQ = 32 * 64, NIT = I_IN + I_UQ + I_UKV + I_OUT + I_PQ;
      for (int it = gw; it < NIT; it += NGW) { int r = it;
          if (r < I_IN) { const int kb = r / 138, nb = r % 138, n0 = nb * 32; int db, ds = 1;
              if (n0 < 1280) db = n0; else if (n0 < 1312) { db = 1280; ds = 2; } else if (n0 < 1344) { db = 1281; ds = 2; } else if (n0 < 2368) db = 1536 + (n0 - 1344); else if (n0 < 3392) db = 2560 + (n0 - 2368); else db = 3584 + (n0 - 3392);
              tr_item(F.a->in[5], DM, 4416, WSP(bf16_t, WS_W_IN), kb * 64, n0, db, ds, nullptr, scr, lane); continue; } r -= I_IN;
          if (r < I_UQ) { const int kb = r / 48, nb = r % 48, n0 = nb * 32, hh = n0 / QKD, j0 = n0 % QKD; int db = n0, ds = 1;
              if (j0 == 128) { db = hh * QKD + 128; ds = 2; } else if (j0 == 160) { db = hh * QKD + 129; ds = 2; }
              tr_item(F.a->in[7], QR, NH * QKD, WSP(bf16_t, WS_W_UQ), kb * 64, n0, db, ds, F.a->in[6] + kb * 64, scr, lane); continue; } r -= I_UQ;
          if (r < I_UKV) { const int kb = r / 64, nb = r % 64, n0 = nb * 32, hh = n0 / 256, j0 = n0 % 256; const int db = (j0 < 128) ? hh * 128 + j0 : 1024 + hh * 128 + (j0 - 128);
              tr_item(F.a->in[9], KVR, 2048, WSP(bf16_t, WS_W_UKV), kb * 64, n0, db, 1, F.a->in[8] + kb * 64, scr, lane); continue; } r -= I_UKV;
          if (r < I_OUT) { const int kb = r / 64, nb = r % 64, k0 = kb * 64; const float* gk = (k0 < MW) ? F.a->in[10] + k0 : F.a->in[11] + (k0 - MW);
              tr_item(F.a->in[12], DM, DM, WSP(bf16_t, WS_W_OUT), k0, nb * 32, nb * 32, 1, gk, scr, lane); continue; } r -= I_OUT;
          { const int kb = r / 64, nb = r % 64; tr_item(F.a->in[15], DM, DM, WSP(bf16_t, WS_W_PQ), kb * 64, nb * 32, nb * 32, 1, nullptr, scr, lane); }
      } }
    { u32x4* z = (u32x4*)(WSP(bf16_t, WS_W_IN) + (size_t)1344 * DM); const int n16 = 192 * DM * 2 / 16;
      for (int i = gt; i < n16; i += NGT) z[i] = (u32x4){0u, 0u, 0u, 0u}; }
    { f32x2* tab = WSP(f32x2, WS_ROPE);
      for (int i = gt; i < SEQ * 32; i += NGT) { const int pos = i >> 5, f = i & 31; double pw = 1.0; for (int k_ = 0; k_ < f; ++k_) pw *= 0.7498942093324558273; const float ang = (float)pos * (float)pw;
          const double rev = (double)ang * 0.15915494309189535; const float fr = (float)(rev - __builtin_floor(rev));
          tab[i] = (f32x2){__builtin_amdgcn_cosf(fr), __builtin_amdgcn_sinf(fr)}; } }
    { for (int tb = 0; tb < 2; ++tb) { const float* src = F.a->in[18 + tb]; unsigned char* dst = WSP(unsigned char, tb ? WS_V : WS_U); float* scl = WSP(float, tb ? WS_VS : WS_US);
          for (int r = gw; r < NEXP; r += NGW) { const float* row = src + (size_t)r * DM; f32x4 v[2][4]; float mx = 0.f;
#pragma unroll
              for (int c = 0; c < 2; ++c)
#pragma unroll
                  for (int q = 0; q < 4; ++q) { v[c][q] = *(const f32x4*)(row + c * 1024 + lane * 16 + q * 4); mx = fmaxf(mx, fmaxf(fmaxf(fabsf(v[c][q][0]), fabsf(v[c][q][1])), fmaxf(fabsf(v[c][q][2]), fabsf(v[c][q][3])))); }
#pragma unroll
              for (int o = 1; o < 64; o <<= 1) mx = fmaxf(mx, __shfl_xor(mx, o));
              const float sc = mx > 0.f ? mx * (tb ? 1.0f / 416.0f : 1.0f / 127.0f) : 1.0f, inv = 1.0f / sc;
              if (lane == 0) scl[r] = sc;
#pragma unroll
              for (int c = 0; c < 2; ++c) { u32x4 o;
#pragma unroll
                  for (int q = 0; q < 4; ++q) {
                      if (tb) { int w = 0; w = __builtin_amdgcn_cvt_pk_fp8_f32(v[c][q][0] * inv, v[c][q][1] * inv, w, false); w = __builtin_amdgcn_cvt_pk_fp8_f32(v[c][q][2] * inv, v[c][q][3] * inv, w, true); o[q] = (unsigned)w; }
                      else o[q] = pack_i8(v[c][q] * inv); }
                  *(u32x4*)(dst + (size_t)(8 * c + (lane >> 3)) * ((size_t)NEXP * 128) + (size_t)r * 128 + 16 * (lane & 7)) = o; } } } }
}

__device__ __forceinline__ void p1_rows(Frame& F) {
    PHASE_TID();
    const int gw = F.vcu * NWAVES + wave, NGW = F.G * NWAVES, wpb = NGW / NB, b = gw / wpb;
    if (b >= NB) return;
    const float* mod = WSP(float, WS_MOD); const float* prm = WSP(float, WS_PRM) + (size_t)b * (4 * DM); bf16_t* H = WSP(bf16_t, WS_H);
    f32x4 pa[8], pb[8];
#pragma unroll
    for (int j = 0; j < 4; ++j) { const int e = 8 * (lane + 64 * j); pa[2 * j] = *(const f32x4*)(prm + e); pa[2 * j + 1] = *(const f32x4*)(prm + e + 4); pb[2 * j] = *(const f32x4*)(mod + b * (6 * DM) + e); pb[2 * j + 1] = *(const f32x4*)(mod + b * (6 * DM) + e + 4); }
    for (int m = b * SEQ + gw % wpb; m < (b + 1) * SEQ; m += wpb) {
        const float* xr = F.a->in[0] + (size_t)m * DM + 8 * lane; f32x4 v[8]; float s = 0.f;
#pragma unroll
        for (int j = 0; j < 4; ++j) { v[2 * j] = *(const f32x4*)(xr + 512 * j); v[2 * j + 1] = *(const f32x4*)(xr + 512 * j + 4); }
#pragma unroll
        for (int j = 0; j < 8; ++j) s += (v[j][0] * v[j][0] + v[j][1] * v[j][1]) + (v[j][2] * v[j][2] + v[j][3] * v[j][3]);
        const float rstd = 1.0f / sqrtf(wave_sum(s) * (1.0f / DM) + EPS);
        bf16_t* o = H + (size_t)m * DM + 8 * lane;
#pragma unroll
        for (int j = 0; j < 4; ++j) { const f32x4 r0 = v[2 * j] * rstd * pa[2 * j] + pb[2 * j], r1 = v[2 * j + 1] * rstd * pa[2 * j + 1] + pb[2 * j + 1];
            *(u32x4*)(o + 512 * j) = (u32x4){cvt_pk_bf16(r0[0], r0[1]), cvt_pk_bf16(r0[2], r0[3]), cvt_pk_bf16(r1[0], r1[1]), cvt_pk_bf16(r1[2], r1[3])}; } }
}

__device__ __forceinline__ void p3_kmean(Frame& F) {
    PHASE_TID();
    const int gw = F.vcu * NWAVES + wave, NGW = F.G * NWAVES, rg = lane >> 4, cl = lane & 15;
    const bf16_t* MK = WSP(bf16_t, WS_MK); bf16_t* KM = WSP(bf16_t, WS_KMEAN);
    for (int it = gw; it < NB * 32 * NH; it += NGW) { const int hh = it & 7, j = (it >> 3) & 31, b = it >> 8;
        const bf16_t* src = MK + ((size_t)b * SEQ + j * 256 + rg) * MW + hh * 128 + cl * 8;
        float a[8];
#pragma unroll
        for (int e = 0; e < 8; ++e) a[e] = 0.f;
        float kmx = 0.f;
#pragma unroll 8
        for (int i = 0; i < 64; ++i) { const u32x4 w = *(const u32x4*)(src + (size_t)(4 * i) * MW);
            const float e0 = bf_lo(w.x), e1 = bf_hi(w.x), e2 = bf_lo(w.y), e3 = bf_hi(w.y), e4 = bf_lo(w.z), e5 = bf_hi(w.z), e6 = bf_lo(w.w), e7 = bf_hi(w.w);
            a[0] += e0; a[1] += e1; a[2] += e2; a[3] += e3; a[4] += e4; a[5] += e5; a[6] += e6; a[7] += e7;
            float q = (e0 * e0 + e1 * e1) + (e2 * e2 + e3 * e3) + (e4 * e4 + e5 * e5) + (e6 * e6 + e7 * e7);
            q += dpp_f<DPP_XOR1>(q); q += dpp_f<DPP_XOR2>(q); q += dpp_f<DPP_HMIRROR>(q); q += dpp_f<DPP_XOR8>(q);
            kmx = fmaxf(kmx, q); }
        kmx = fmaxf(kmx, __shfl_xor(kmx, 16)); kmx = fmaxf(kmx, __shfl_xor(kmx, 32));
        if (lane == 0) WSP(float, WS_KMAX)[(b * NH + hh) * 32 + j] = sqrtf(kmx);
#pragma unroll
        for (int e = 0; e < 8; ++e) { a[e] += __shfl_xor(a[e], 16); a[e] += __shfl_xor(a[e], 32); a[e] *= (1.0f / 256.0f); }
        if (rg == 0) { u32x4 o; o.x = cvt_pk_bf16(a[0], a[1]); o.y = cvt_pk_bf16(a[2], a[3]); o.z = cvt_pk_bf16(a[4], a[5]); o.w = cvt_pk_bf16(a[6], a[7]);
            *(u32x4*)(KM + ((size_t)((b * NH + hh) * 32 + j)) * 128 + cl * 8) = o; } }
}

__device__ __forceinline__ void p6_rows(Frame& F) {
    PHASE_TID();
    const int gw = F.vcu * NWAVES + wave, NGW = F.G * NWAVES, wpb = NGW / NB, b = gw / wpb;
    if (b >= NB) return;
    const float* mod = WSP(float, WS_MOD); const float* prm = WSP(float, WS_PRM) + (size_t)b * (4 * DM); const epi::fx_t* ssy = CTL_FX(CW_SSY); const bf16_t* Y = WSP(bf16_t, WS_Y); bf16_t* H = WSP(bf16_t, WS_H);
    f32x4 qa[8], qb[8], qc[8];
#pragma unroll
    for (int j = 0; j < 4; ++j) { const int e = 8 * (lane + 64 * j);
        qa[2 * j] = *(const f32x4*)(prm + DM + e); qa[2 * j + 1] = *(const f32x4*)(prm + DM + e + 4); qb[2 * j] = *(const f32x4*)(prm + 2 * DM + e); qb[2 * j + 1] = *(const f32x4*)(prm + 2 * DM + e + 4);
        qc[2 * j] = *(const f32x4*)(mod + b * (6 * DM) + 3 * DM + e); qc[2 * j + 1] = *(const f32x4*)(mod + b * (6 * DM) + 3 * DM + e + 4); }
    for (int m = b * SEQ + gw % wpb; m < (b + 1) * SEQ; m += wpb) {
        const float* xr = F.a->in[0] + (size_t)m * DM + 8 * lane; const bf16_t* yr = Y + (size_t)m * DM + 8 * lane;
        const float ry = 1.0f / sqrtf(epi::fx2f(ssy[m]) * (1.0f / DM) + EPS);
        f32x4 v[8]; float s = 0.f;
#pragma unroll
        for (int j = 0; j < 4; ++j) { const f32x4 x0 = *(const f32x4*)(xr + 512 * j), x1 = *(const f32x4*)(xr + 512 * j + 4); const u32x4 yw = *(const u32x4*)(yr + 512 * j);
            const f32x4 y0 = {bf_lo(yw.x), bf_hi(yw.x), bf_lo(yw.y), bf_hi(yw.y)}, y1 = {bf_lo(yw.z), bf_hi(yw.z), bf_lo(yw.w), bf_hi(yw.w)};
            v[2 * j] = x0 + qa[2 * j] * (y0 * ry); v[2 * j + 1] = x1 + qa[2 * j + 1] * (y1 * ry); }
#pragma unroll
        for (int j = 0; j < 8; ++j) s += (v[j][0] * v[j][0] + v[j][1] * v[j][1]) + (v[j][2] * v[j][2] + v[j][3] * v[j][3]);
        const float rstd = 1.0f / sqrtf(wave_sum(s) * (1.0f / DM) + EPS);
        bf16_t* xo = WSP(bf16_t, WS_X1B) + (size_t)m * DM + 8 * lane; bf16_t* ho = H + (size_t)m * DM + 8 * lane;
        unsigned char* h8o = WSP(unsigned char, WS_H8) + (size_t)m * DM + 8 * lane; float* hso = WSP(float, WS_HS) + (size_t)m * 16;
#pragma unroll
        for (int j = 0; j < 4; ++j) { *(u32x4*)(xo + 512 * j) = (u32x4){cvt_pk_bf16(v[2 * j][0], v[2 * j][1]), cvt_pk_bf16(v[2 * j][2], v[2 * j][3]), cvt_pk_bf16(v[2 * j + 1][0], v[2 * j + 1][1]), cvt_pk_bf16(v[2 * j + 1][2], v[2 * j + 1][3])};
            const f32x4 r0 = v[2 * j] * rstd * qb[2 * j] + qc[2 * j], r1 = v[2 * j + 1] * rstd * qb[2 * j + 1] + qc[2 * j + 1];
            *(u32x4*)(ho + 512 * j) = (u32x4){cvt_pk_bf16(r0[0], r0[1]), cvt_pk_bf16(r0[2], r0[3]), cvt_pk_bf16(r1[0], r1[1]), cvt_pk_bf16(r1[2], r1[3])};
            float am = fmaxf(fmaxf(fmaxf(fabsf(r0[0]), fabsf(r0[1])), fmaxf(fabsf(r0[2]), fabsf(r0[3]))), fmaxf(fmaxf(fabsf(r1[0]), fabsf(r1[1])), fmaxf(fabsf(r1[2]), fabsf(r1[3]))));
            am = fmaxf(am, dpp_f<DPP_XOR1>(am)); am = fmaxf(am, dpp_f<DPP_XOR2>(am)); am = fmaxf(am, dpp_f<DPP_HMIRROR>(am)); am = fmaxf(am, dpp_f<DPP_XOR8>(am));
            const float hsc = am > 0.f ? am * (1.0f / 127.0f) : 1.0f, hin = 1.0f / hsc;
            *(u32x2*)(h8o + 512 * j) = (u32x2){pack_i8(r0 * hin), pack_i8(r1 * hin)};
            if ((lane & 15) == 0) hso[4 * j + (lane >> 4)] = hsc; } }
}

__device__ __forceinline__ unsigned f2key(float f) { const unsigned u = __float_as_uint(f); return u ^ ((unsigned)((int)u >> 31) | 0x80000000u); }
__device__ __forceinline__ float key2f(unsigned k) { return __uint_as_float(k ^ ((k >> 31) ? 0x80000000u : 0xffffffffu)); }
__device__ __forceinline__ unsigned med3u(unsigned a, unsigned b, unsigned c) { unsigned r; asm("v_med3_u32 %0, %1, %2, %3" : "=v"(r) : "v"(a), "v"(b), "v"(c)); return r; }
__device__ __forceinline__ void p9_topk(Frame& F) {
    const float* SC = WSP(float, WS_SC); int* IDS = WSP(int, WS_IDS); float* GW = WSP(float, WS_G); float* UP = WSP(float, WS_UP); const float* US = WSP(float, WS_US); const float* VS = WSP(float, WS_VS);
    PHASE_TID();
    const int hh = wave;
    for (int blk = F.vcu; blk < NT / 64; blk += F.G) { const int tok = blk * 64 + lane;
        unsigned t1[16], t2[16];
#pragma unroll
        for (int i = 0; i < 16; ++i) { t1[i] = 0u; t2[i] = 0u; }
        const float* sp = SC + (size_t)(hh * 256) * NT + tok;
        float xa1[16], xa2[16], xb1[16], xb2[16];
        auto ldb = [&](float* x1, float* x2, int n0) {
#pragma unroll
            for (int u = 0; u < 16; ++u) { x1[u] = sp[(size_t)(n0 + u) * NT]; x2[u] = sp[(size_t)(128 + n0 + u) * NT]; } };
        auto ins = [&](const float* x1, const float* x2, int n0) {
#pragma unroll
            for (int u = 0; u < 16; ++u) { const unsigned k = (f2key(x1[u]) & ~127u) | (unsigned)(127 - (n0 + u)), k2 = (f2key(x2[u]) & ~127u) | (unsigned)(127 - (n0 + u));
#pragma unroll
                for (int i = 15; i >= 1; --i) { t1[i] = med3u(t1[i - 1], t1[i], k); t2[i] = med3u(t2[i - 1], t2[i], k2); }
                t1[0] = max(t1[0], k); t2[0] = max(t2[0], k2); } };
        ldb(xa1, xa2, 0);
#pragma unroll 1
        for (int n0 = 0; n0 < 128; n0 += 32) {
            ldb(xb1, xb2, n0 + 16); __builtin_amdgcn_sched_barrier(0);
            ins(xa1, xa2, n0); __builtin_amdgcn_sched_barrier(0);
            ldb(xa1, xa2, n0 + 32 < 128 ? n0 + 32 : 0); __builtin_amdgcn_sched_barrier(0);
            ins(xb1, xb2, n0 + 16); __builtin_amdgcn_sched_barrier(0);
        }
        LAS int* tab = (LAS int*)(F.lds + wave * 8192) + lane;
#pragma unroll
        for (int i = 0; i < 16; ++i) { tab[i * 64] = 127 - (int)(t1[i] & 127u); tab[(16 + i) * 64] = 127 - (int)(t2[i] & 127u); }
        unsigned ck[16]; int cid[16];
#pragma unroll
        for (int i = 0; i < 16; ++i) ck[i] = 0u;
#pragma unroll
        for (int i = 0; i < 16; ++i) {
            if (F.G + 100 > i) {
                const float v1 = key2f((t1[i] & ~127u) | 64u);
#pragma unroll
                for (int j = 0; j < 16; ++j) { if ((i + 1) * (j + 1) <= 16) {
                    const float v2 = key2f((t2[j] & ~127u) | 64u); const unsigned k = (f2key(v1 + v2) & ~255u) | (unsigned)(255 - (16 * i + j));
#pragma unroll
                    for (int q = 15; q >= 1; --q) ck[q] = med3u(ck[q - 1], ck[q], k);
                    ck[0] = max(ck[0], k); } }
            }
        }
#pragma unroll
        for (int q = 0; q < 16; ++q) { const int idx = 255 - (int)(ck[q] & 255u); cid[q] = tab[(idx >> 4) * 64] * NKEY + tab[(16 + (idx & 15)) * 64]; ck[q] = (ck[q] & ~255u) | 128u; }
        const float top = key2f(ck[0]); float e[16], sum = 0.f;
#pragma unroll
        for (int q = 0; q < 16; ++q) { e[q] = __expf(key2f(ck[q]) - top); sum += e[q]; }
        const float inv = 1.0f / sum;
        int* ip = IDS + (size_t)tok * 128 + hh * 16; float* gp = GW + (size_t)tok * 128 + hh * 16; float* up = UP + (size_t)tok * 128 + hh * 16;
#pragma unroll
        for (int q = 0; q < 16; q += 4) { *(int4*)(ip + q) = make_int4(cid[q], cid[q + 1], cid[q + 2], cid[q + 3]);
            *(f32x4*)(gp + q) = (f32x4){e[q] * inv * VS[cid[q]], e[q + 1] * inv * VS[cid[q + 1]], e[q + 2] * inv * VS[cid[q + 2]], e[q + 3] * inv * VS[cid[q + 3]]};
            *(f32x4*)(up + q) = (f32x4){US[cid[q]], US[cid[q + 1]], US[cid[q + 2]], US[cid[q + 3]]}; }
    }
}


__device__ __forceinline__ void p9_scores_topk(Frame& F) {
    unsigned short* IDS = WSP(unsigned short, WS_IDS); float* GW = WSP(float, WS_G); float* UP = WSP(float, WS_UP); const float* US = WSP(float, WS_US); const float* VS = WSP(float, WS_VS); const bf16_t* QP = WSP(bf16_t, WS_QP);
    PHASE_TID();
    const int tid = wave * 64 + lane, r32 = lane & 31, hi = lane >> 5;
    const int nwh = F.G / NH; if (F.vcu >= nwh * NH) return;
    const int hh = F.vcu % NH, wrank = F.vcu / NH;
    constexpr int KST2 = 272;
    for (int e = 0; e < 2; ++e) { const float* src = F.a->in[16 + e] + (size_t)hh * 128 * 128;
        for (int c = tid; c < 128 * 16; c += NWAVES * 64) { const int row = c >> 4, c8 = (c & 15) * 8; const f32x4 a = *(const f32x4*)(src + row * 128 + c8), b = *(const f32x4*)(src + row * 128 + c8 + 4);
            u32x4 o; o.x = cvt_pk_bf16(a[0], a[1]); o.y = cvt_pk_bf16(a[2], a[3]); o.z = cvt_pk_bf16(b[0], b[1]); o.w = cvt_pk_bf16(b[2], b[3]);
            *(LAS u32x4*)(F.lds + e * (128 * KST2) + row * KST2 + c8 * 2) = o; } }
    __syncthreads();
    const int ntg = NT / 32;
    auto ldq = [&](bf16x8* qf, int tg_, int e) { const int tgc = tg_ < ntg ? tg_ : wrank * NWAVES + wave; const bf16_t* qp = QP + ((size_t)((tgc * 8 + hh) * 2 + e)) * (8 * 512) + lane * 8;
#pragma unroll
        for (int s = 0; s < 8; ++s) qf[s] = *(const bf16x8*)(qp + 512 * s); };
    bf16x8 qa[8], qb[8];
    if (wrank * NWAVES + wave < ntg) ldq(qa, wrank * NWAVES + wave, 0);
    for (int tg = wrank * NWAVES + wave; tg < ntg; tg += nwh * NWAVES) { const int tok = tg * 32 + r32;
        unsigned t1[16], t2[16];
#pragma unroll
        for (int i = 0; i < 16; ++i) { t1[i] = 0u; t2[i] = 0u; }
        auto rank_set = [&](const bf16x8 (&qf)[8], unsigned (&t)[16], const int e) {
            LAS unsigned char* kb0 = F.lds + e * (128 * KST2) + r32 * KST2 + hi * 16;
#pragma unroll
            for (int kb = 0; kb < 4; ++kb) { f32x16 acc = {};
#pragma unroll
                for (int s = 0; s < 8; ++s) acc = attn::mfma32(*(const LAS bf16x8*)(kb0 + kb * 32 * KST2 + s * 32), qf[s], acc);
#pragma unroll
                for (int r = 0; r < 16; ++r) { const int key = 32 * kb + (r & 3) + 8 * (r >> 2) + 4 * hi; const unsigned k = (f2key(acc[r]) & ~127u) | (unsigned)(127 - key);
#pragma unroll
                    for (int i = 15; i >= 1; --i) t[i] = med3u(t[i - 1], t[i], k);
                    t[0] = max(t[0], k); } } };
        ldq(qb, tg, 1); __builtin_amdgcn_sched_barrier(0);
        rank_set(qa, t1, 0); __builtin_amdgcn_sched_barrier(0);
        ldq(qa, tg + nwh * NWAVES, 0); __builtin_amdgcn_sched_barrier(0);
        rank_set(qb, t2, 1); __builtin_amdgcn_sched_barrier(0);
        unsigned p1[16], p2[16];
#pragma unroll
        for (int i = 0; i < 16; ++i) { const auto ra = __builtin_amdgcn_permlane32_swap(t1[i], t1[i], false, false), rb = __builtin_amdgcn_permlane32_swap(t2[i], t2[i], false, false);
            p1[i] = hi ? ra[0] : ra[1]; p2[i] = hi ? rb[0] : rb[1]; }
#pragma unroll
        for (int u = 0; u < 16; ++u) { const unsigned k = p1[u], k2 = p2[u];
#pragma unroll
            for (int i = 15; i >= 1; --i) { t1[i] = med3u(t1[i - 1], t1[i], k); t2[i] = med3u(t2[i - 1], t2[i], k2); }
            t1[0] = max(t1[0], k); t2[0] = max(t2[0], k2); }
        LAS int* tab = (LAS int*)(F.lds + 69632 + wave * 4096) + r32;
#pragma unroll
        for (int i = 0; i < 16; ++i) { tab[i * 32] = 127 - (int)(t1[i] & 127u); tab[(16 + i) * 32] = 127 - (int)(t2[i] & 127u); }
        unsigned ck[16]; int cid[16];
#pragma unroll
        for (int i = 0; i < 16; ++i) ck[i] = 0u;
#pragma unroll
        for (int i = 0; i < 16; ++i) {
            if (F.G + 100 > i) {
                const float v1 = key2f((t1[i] & ~127u) | 64u);
#pragma unroll
                for (int j = 0; j < 16; ++j) { if ((i + 1) * (j + 1) <= 16) {
                    const float v2 = key2f((t2[j] & ~127u) | 64u); const unsigned k = (f2key(v1 + v2) & ~255u) | (unsigned)(255 - (16 * i + j));
#pragma unroll
                    for (int q = 15; q >= 1; --q) ck[q] = med3u(ck[q - 1], ck[q], k);
                    ck[0] = max(ck[0], k); } }
            }
        }
#pragma unroll
        for (int q = 0; q < 16; ++q) { const int idx = 255 - (int)(ck[q] & 255u); cid[q] = tab[(idx >> 4) * 32] * NKEY + tab[(16 + (idx & 15)) * 32]; ck[q] = (ck[q] & ~255u) | 128u; }
        const float top = key2f(ck[0]); float e[16], sum = 0.f;
#pragma unroll
        for (int q = 0; q < 16; ++q) { e[q] = __expf(key2f(ck[q]) - top); sum += e[q]; }
        const float inv = 1.0f / sum;
        unsigned short* ip = IDS + (size_t)tok * 128 + hh * 16; float* gp = GW + (size_t)tok * 128 + hh * 16; float* up = UP + (size_t)tok * 128 + hh * 16;
        if (hi == 0)
#pragma unroll
        for (int q = 0; q < 16; q += 4) { *(u32x2*)(ip + q) = (u32x2){(unsigned)cid[q] | ((unsigned)cid[q + 1] << 16), (unsigned)cid[q + 2] | ((unsigned)cid[q + 3] << 16)};
            *(f32x4*)(gp + q) = (f32x4){e[q] * inv * VS[cid[q]], e[q + 1] * inv * VS[cid[q + 1]], e[q + 2] * inv * VS[cid[q + 2]], e[q + 3] * inv * VS[cid[q + 3]]};
            *(f32x4*)(up + q) = (f32x4){US[cid[q]], US[cid[q + 1]], US[cid[q + 2]], US[cid[q + 3]]}; }
    }
}

__device__ __forceinline__ float gelu_erf(float v) {
    const float av = fabsf(v), t = __builtin_amdgcn_rcpf(fmaf(av, 0.2316418882f, 1.0f));
    float q = fmaf(t, 0.5307027145f, -0.7265760135f); q = fmaf(q, t, 0.7107068705f); q = fmaf(q, t, -0.142248368f); q = fmaf(q, t, 0.127414796f); q = q * t;
    const float e = __builtin_amdgcn_exp2f(v * v * -0.72134752044f), mm = v * (q * e);
    return v < 0.f ? mm : v - mm;
}
__device__ __forceinline__ float dot16(u32x4 a, const f32x2* hf, float acc0) {
    f32x2 acc = {acc0, 0.f};
#pragma unroll
    for (int q = 0; q < 4; ++q) { const f32x2 lo = __builtin_amdgcn_cvt_pk_f32_fp8((int)a[q], false), hi = __builtin_amdgcn_cvt_pk_f32_fp8((int)a[q], true);
        acc = __builtin_elementwise_fma(lo, hf[2 * q], acc); acc = __builtin_elementwise_fma(hi, hf[2 * q + 1], acc); }
    return acc.x + acc.y;
}
typedef __attribute__((address_space(1))) const u32x4 g_u32x4;
__device__ __forceinline__ unsigned long long uniform_addr(const void* p) {
    const unsigned long long v = (unsigned long long)p; const unsigned lo = __builtin_amdgcn_readfirstlane((unsigned)v), hi = __builtin_amdgcn_readfirstlane((unsigned)(v >> 32));
    return ((unsigned long long)hi << 32) | lo; }
__device__ __forceinline__ void p11_pdots(Frame& F) {
    PHASE_TID();
    const unsigned char* U = WSP(unsigned char, WS_U); const unsigned char* H8 = WSP(unsigned char, WS_H8); const float* HS = WSP(float, WS_HS);
    const unsigned short* IDS = WSP(unsigned short, WS_IDS); bf16_t* PD = WSP(bf16_t, WS_PD); bf16_t* dead = WSP(bf16_t, WS_MODP);
    const int lw = F.xrank * NWAVES + wave, nlw = F.xloc * NWAVES;
    for (int sl = F.xidx; sl < 16; sl += F.xn) {
        const unsigned long long Us = uniform_addr(U + (size_t)sl * ((size_t)NEXP * 128)); bf16_t* PDs = PD + (size_t)sl * NT * 128;
        struct Tk { int i0, i1; };
        struct Rw { u32x4 r[16]; u32x4 h; float hs; };
        Tk mA, mB; Rw bA, bB;
        int ln = lane; asm volatile("" : "+v"(ln));
        const unsigned c16 = 16 * (ln & 7);
        auto meta = [&](Tk& m, int tk_) { const int tk = tk_ < NT ? tk_ : lw;
            m.i0 = IDS[(size_t)tk * 128 + ln]; m.i1 = IDS[(size_t)tk * 128 + 64 + ln]; };
        auto issue = [&](Rw& b, const Tk& m, int tk_) { const int tk = tk_ < NT ? tk_ : lw;
            b.h = *(const u32x4*)(H8 + (size_t)tk * DM + sl * 128 + c16); b.hs = HS[(size_t)tk * 16 + sl];
            __builtin_amdgcn_sched_barrier(0);
#pragma unroll
            for (int i = 0; i < 16; ++i) { const int src = (8 * i + (ln >> 3)) & 63; const unsigned ek = (unsigned)__shfl(i < 8 ? m.i0 : m.i1, src);
                b.r[i] = *(g_u32x4*)(Us + (ek * 128u + c16)); } };
        auto compute = [&](const Rw& b, const int tok, const bool real) {
            int d[16];
#pragma unroll
            for (int i = 0; i < 16; ++i) { int a;
                asm("v_dot4_i32_i8 %0, %1, %2, 0" : "=v"(a) : "v"(b.r[i][0]), "v"(b.h[0]));
#pragma unroll
                for (int q = 1; q < 4; ++q) a = __builtin_amdgcn_sdot4((int)b.r[i][q], (int)b.h[q], a, false);
                d[i] = a; }
            int r8[8], r4[4], r2[2];
            { const bool up = ln & 4;
#pragma unroll
              for (int j = 0; j < 8; ++j) { const int snd = up ? d[j] : d[j + 8], keep = up ? d[j + 8] : d[j]; r8[j] = keep + dpp_i<DPP_HMIRROR>(snd); } }
            { const bool up = ln & 2;
#pragma unroll
              for (int j = 0; j < 4; ++j) { const int snd = up ? r8[j] : r8[j + 4], keep = up ? r8[j + 4] : r8[j]; r4[j] = keep + dpp_i<DPP_XOR2>(snd); } }
            { const bool up = ln & 1;
#pragma unroll
              for (int j = 0; j < 2; ++j) { const int snd = up ? r4[j] : r4[j + 2], keep = up ? r4[j + 2] : r4[j]; r2[j] = keep + dpp_i<DPP_XOR1>(snd); } }
            bf16_t* pp = (real ? PDs + (size_t)tok * 128 : dead) + 2 * ln;
            *(unsigned*)pp = cvt_pk_bf16((float)r2[0] * b.hs, (float)r2[1] * b.hs);
        };
        if (lw < NT) {
            meta(mA, lw); meta(mB, lw + nlw);
            __builtin_amdgcn_sched_barrier(0);
            issue(bA, mA, lw); meta(mA, lw + 2 * nlw);
            __builtin_amdgcn_sched_barrier(0);
            for (int tok = lw; tok < NT; tok += 2 * nlw) {
                issue(bB, mB, tok + nlw); meta(mB, tok + 3 * nlw);
                __builtin_amdgcn_sched_barrier(0);
                compute(bA, tok, true);
                __builtin_amdgcn_sched_barrier(0);
                issue(bA, mA, tok + 2 * nlw); meta(mA, tok + 4 * nlw);
                __builtin_amdgcn_sched_barrier(0);
                compute(bB, tok + nlw, tok + nlw < NT);
                __builtin_amdgcn_sched_barrier(0);
            }
        }
    }
}
__device__ __forceinline__ void p11_coef(Frame& F) {
    PHASE_TID();
    const bf16_t* PD = WSP(bf16_t, WS_PD); const float* UP = WSP(float, WS_UP); const float* GW = WSP(float, WS_G); unsigned char* T8 = WSP(unsigned char, WS_T8); float* S0 = WSP(float, WS_S0);
    const int gt = (F.vcu * NWAVES + wave) * 64 + lane, NGT = F.G * NWAVES * 64;
    for (int i = gt; i < NT * 128 / 4; i += NGT) { f32x4 s = {0.f, 0.f, 0.f, 0.f};
#pragma unroll
        for (int sl = 0; sl < 16; ++sl) { const u32x2 w = *(const u32x2*)(PD + (size_t)sl * NT * 128 + (size_t)i * 4); s += (f32x4){bf_lo(w.x), bf_hi(w.x), bf_lo(w.y), bf_hi(w.y)}; }
        const int p0 = (i & 31) * 4, k0 = 16 * ((p0 >> 1) & 7) + (p0 >> 4); const int t = i >> 5; const size_t tb = (size_t)t * 128;
        float a[4];
#pragma unroll
        for (int e_ = 0; e_ < 4; ++e_) { const size_t o = tb + k0 + 8 * e_; a[e_] = gelu_erf(s[e_] * UP[o]) * GW[o]; }
        float am = fmaxf(fmaxf(fabsf(a[0]), fabsf(a[1])), fmaxf(fabsf(a[2]), fabsf(a[3])));
        am = fmaxf(am, dpp_f<DPP_XOR1>(am)); am = fmaxf(am, dpp_f<DPP_XOR2>(am)); am = fmaxf(am, dpp_f<DPP_HMIRROR>(am)); am = fmaxf(am, dpp_f<DPP_XOR8>(am)); am = fmaxf(am, __shfl_xor(am, 16));
        const float s0 = am > 0.f ? am * (1.0f / 256.0f) : 1.0f, inv = 1.0f / s0;
        if ((lane & 31) == 0) S0[t] = s0;
        unsigned q0 = 0u, q1 = 0u;
#pragma unroll
        for (int e_ = 0; e_ < 4; ++e_) { const float x = a[e_] * inv;
            const int w0 = __builtin_amdgcn_cvt_pk_fp8_f32(x, 0.f, 0, false) & 255; const f32x2 d0 = __builtin_amdgcn_cvt_pk_f32_fp8(w0, false); const float r1 = (x - d0.x) * 16.0f;
            const int w1 = __builtin_amdgcn_cvt_pk_fp8_f32(r1, 0.f, 0, false) & 255;
            q0 |= (unsigned)w0 << (8 * e_); q1 |= (unsigned)w1 << (8 * e_); }
        { unsigned char* tp = T8 + (size_t)t * 256 + 16 * (k0 & 7) + (k0 >> 3); *(unsigned*)tp = q0; *(unsigned*)(tp + 128) = q1; } }
}
__device__ __forceinline__ void p12_axpy(Frame& F) {
    PHASE_TID();
    const unsigned char* V = WSP(unsigned char, WS_V); const unsigned char* T8 = WSP(unsigned char, WS_T8); const float* S0 = WSP(float, WS_S0);
    const unsigned short* IDS = WSP(unsigned short, WS_IDS); bf16_t* Y2 = WSP(bf16_t, WS_Y2); bf16_t* dead = WSP(bf16_t, WS_MODP);
    const int lw = F.xrank * NWAVES + wave, nlw = F.xloc * NWAVES;
    for (int sl = F.xidx; sl < 16; sl += F.xn) {
        const unsigned long long Vs = uniform_addr(V + (size_t)sl * ((size_t)NEXP * 128));
        struct Tk { int i0, i1; };
        struct Rw { u32x4 r[16]; u32x4 ta; float s0; };
        Tk mA, mB; Rw bA, bB;
        int ln = lane; asm volatile("" : "+v"(ln));
        const unsigned c16 = 16 * (ln & 7);
        const int mrow = ln & 15, kb = ln >> 4;
        const bool tv = mrow < 4;
        const int toff = tv ? (mrow & 1) * 128 + 16 * (2 * kb + (mrow >> 1)) : 0;
        auto meta = [&](Tk& m, int tk_) { const int tk = tk_ < NT ? tk_ : lw;
            const size_t o = (size_t)tk * 128 + ln; m.i0 = IDS[o]; m.i1 = IDS[o + 64]; };
        auto issue = [&](Rw& b, const Tk& m, int tk_) { const int tk = tk_ < NT ? tk_ : lw;
#pragma unroll
            for (int i = 0; i < 16; ++i) { const int src = (8 * i + (ln >> 3)) & 63; const unsigned ek = (unsigned)__shfl(i < 8 ? m.i0 : m.i1, src);
                b.r[i] = *(g_u32x4*)(Vs + (ek * 128u + c16)); }
            b.ta = *(const u32x4*)(T8 + (size_t)tk * 256 + toff); b.s0 = S0[tk]; };
        auto compute = [&](const Rw& b, const int tok, const bool real) {
            const unsigned a0 = tv ? b.ta.x : 0u, a1 = tv ? b.ta.y : 0u, a2 = tv ? b.ta.z : 0u, a3 = tv ? b.ta.w : 0u;
            const long av0 = (long)(((unsigned long long)a1 << 32) | a0), av1 = (long)(((unsigned long long)a3 << 32) | a2);
            unsigned pk[8];
#pragma unroll
            for (int hf = 0; hf < 2; ++hf) {
                f32x4 acc[8];
#pragma unroll
                for (int x = 0; x < 8; ++x) acc[x] = (f32x4){0.f, 0.f, 0.f, 0.f};
#pragma unroll
                for (int qq = 0; qq < 2; ++qq) { const int q = 2 * hf + qq;
#pragma unroll
                    for (int be = 0; be < 2; ++be) {
                        unsigned cl[4], ch[4];
                        { const unsigned r0 = b.r[8 * be][q], r1 = b.r[8 * be + 1][q], r2 = b.r[8 * be + 2][q], r3 = b.r[8 * be + 3][q];
                          const unsigned t01l = __builtin_amdgcn_perm(r1, r0, 0x05010400u), t01h = __builtin_amdgcn_perm(r1, r0, 0x07030602u), t23l = __builtin_amdgcn_perm(r3, r2, 0x05010400u), t23h = __builtin_amdgcn_perm(r3, r2, 0x07030602u);
                          cl[0] = __builtin_amdgcn_perm(t23l, t01l, 0x05040100u); cl[1] = __builtin_amdgcn_perm(t23l, t01l, 0x07060302u); cl[2] = __builtin_amdgcn_perm(t23h, t01h, 0x05040100u); cl[3] = __builtin_amdgcn_perm(t23h, t01h, 0x07060302u); }
                        { const unsigned r0 = b.r[8 * be + 4][q], r1 = b.r[8 * be + 5][q], r2 = b.r[8 * be + 6][q], r3 = b.r[8 * be + 7][q];
                          const unsigned t01l = __builtin_amdgcn_perm(r1, r0, 0x05010400u), t01h = __builtin_amdgcn_perm(r1, r0, 0x07030602u), t23l = __builtin_amdgcn_perm(r3, r2, 0x05010400u), t23h = __builtin_amdgcn_perm(r3, r2, 0x07030602u);
                          ch[0] = __builtin_amdgcn_perm(t23l, t01l, 0x05040100u); ch[1] = __builtin_amdgcn_perm(t23l, t01l, 0x07060302u); ch[2] = __builtin_amdgcn_perm(t23h, t01h, 0x05040100u); ch[3] = __builtin_amdgcn_perm(t23h, t01h, 0x07060302u); }
#pragma unroll
                        for (int x = 0; x < 4; ++x) { const long bv = (long)(((unsigned long long)ch[x] << 32) | cl[x]);
                            acc[4 * qq + x] = __builtin_amdgcn_mfma_f32_16x16x32_fp8_fp8(be ? av1 : av0, bv, acc[4 * qq + x], 0, 0, 0); } } }
                float yv[8];
                const bool lo8 = (ln & 8) == 0;
#pragma unroll
                for (int x = 0; x < 8; ++x) { float va = fmaf(acc[x][1], 0.0625f, acc[x][0]), vb = fmaf(acc[x][3], 0.0625f, acc[x][2]);
                    asm volatile("" : "+v"(va), "+v"(vb));
                    const float v = lo8 ? va : vb;
                    yv[x] = b.s0 * (v + __uint_as_float(__builtin_amdgcn_update_dpp(0u, __float_as_uint(v), DPP_XOR8, 0xf, 0xf, true))); }
#pragma unroll
                for (int x = 0; x < 4; ++x) pk[4 * hf + x] = cvt_pk_bf16(yv[2 * x], yv[2 * x + 1]);
            }
            if (ln < 8) { bf16_t* yp = (real ? Y2 + ((size_t)sl * NT + tok) * 128 : dead) + 16 * ln;
                *(u32x4*)yp = (u32x4){pk[0], pk[1], pk[2], pk[3]}; *(u32x4*)(yp + 8) = (u32x4){pk[4], pk[5], pk[6], pk[7]}; }
        };
        if (lw < NT) {
            meta(mA, lw); meta(mB, lw + nlw);
            __builtin_amdgcn_sched_barrier(0);
            issue(bA, mA, lw); meta(mA, lw + 2 * nlw);
            __builtin_amdgcn_sched_barrier(0);
            for (int tok = lw; tok < NT; tok += 2 * nlw) {
                issue(bB, mB, tok + nlw); meta(mB, tok + 3 * nlw);
                __builtin_amdgcn_sched_barrier(0);
                compute(bA, tok, true);
                __builtin_amdgcn_sched_barrier(0);
                issue(bA, mA, tok + 2 * nlw); meta(mA, tok + 4 * nlw);
                __builtin_amdgcn_sched_barrier(0);
                compute(bB, tok + nlw, tok + nlw < NT);
                __builtin_amdgcn_sched_barrier(0);
            }
        }
    }
}
__device__ __forceinline__ void p13_rows(Frame& F) {
    PHASE_TID();
    const int gw = F.vcu * NWAVES + wave, NGW = F.G * NWAVES, wpb = NGW / NB, b = gw / wpb;
    if (b >= NB) return;
    const float* prm = WSP(float, WS_PRM) + (size_t)b * (4 * DM); const bf16_t* Y2 = WSP(bf16_t, WS_Y2);
    f32x4 ra[8];
#pragma unroll
    for (int j = 0; j < 4; ++j) { const int e = 8 * (lane + 64 * j); ra[2 * j] = *(const f32x4*)(prm + 3 * DM + e); ra[2 * j + 1] = *(const f32x4*)(prm + 3 * DM + e + 4); }
    for (int m = b * SEQ + gw % wpb; m < (b + 1) * SEQ; m += wpb) {
        float* xr = F.out + (size_t)m * DM + 8 * lane; const bf16_t* x1r = WSP(bf16_t, WS_X1B) + (size_t)m * DM + 8 * lane; const bf16_t* yr = Y2 + ((size_t)(lane >> 4) * NT + m) * 128 + 8 * (lane & 15);
        u32x4 yw[4]; float s = 0.f;
#pragma unroll
        for (int j = 0; j < 4; ++j) yw[j] = *(const u32x4*)(yr + (size_t)(4 * j) * NT * 128);
#pragma unroll
        for (int j = 0; j < 4; ++j) { const float a0 = bf_lo(yw[j].x), a1 = bf_hi(yw[j].x), a2 = bf_lo(yw[j].y), a3 = bf_hi(yw[j].y), a4 = bf_lo(yw[j].z), a5 = bf_hi(yw[j].z), a6 = bf_lo(yw[j].w), a7 = bf_hi(yw[j].w);
            s += ((a0 * a0 + a1 * a1) + (a2 * a2 + a3 * a3)) + ((a4 * a4 + a5 * a5) + (a6 * a6 + a7 * a7)); }
        const float ry = 1.0f / sqrtf(wave_sum(s) * (1.0f / DM) + EPS);
#pragma unroll
        for (int j = 0; j < 4; ++j) { const u32x4 xw = *(const u32x4*)(x1r + 512 * j); const f32x4 x0 = {bf_lo(xw.x), bf_hi(xw.x), bf_lo(xw.y), bf_hi(xw.y)}, x1 = {bf_lo(xw.z), bf_hi(xw.z), bf_lo(xw.w), bf_hi(xw.w)};
            const f32x4 y0 = {bf_lo(yw[j].x), bf_hi(yw[j].x), bf_lo(yw[j].y), bf_hi(yw[j].y)}, y1 = {bf_lo(yw[j].z), bf_hi(yw[j].z), bf_lo(yw[j].w), bf_hi(yw[j].w)};
            *(f32x4*)(xr + 512 * j) = x0 + ra[2 * j] * (y0 * ry); *(f32x4*)(xr + 512 * j + 4) = x1 + ra[2 * j + 1] * (y1 * ry); } }
}
constexpr int N_PHASES = 15;

__global__ void __launch_bounds__(NWAVES * 64, 2) hymba_fwd(Args args) {
    extern __shared__ __attribute__((aligned(16))) unsigned char lds_raw[];
    Frame F;
    F.lds = (LAS unsigned char*)lds_raw;
    F.G = gridDim.x; { const int bx = blockIdx.x; F.vcu = (F.G % 8 == 0) ? (bx % 8) * (F.G / 8) + bx / 8 : bx; }
    F.a = &args;
    F.out = args.out; F.ws = args.ws; F.ctlf = (float*)(args.ws + WS_CTL);
    volatile LAS unsigned* MISC = (volatile LAS unsigned*)(F.lds + LDSCTL_OFF);
    for (int u = threadIdx.x; u < (LDS_BYTES - LDSCTL_OFF) / 4; u += NWAVES * 64) ((LAS unsigned*)(F.lds + LDSCTL_OFF))[u] = 0u;
    __syncthreads();
    const int lo = args.ph_lo, hi = args.ph_hi;
    XcdBarrier bar; bar.bar = (unsigned*)(F.ctlf) + CW_BAR; bar.x = 0; bar.st = MISC + 8;
    if (hi - lo > 1) bar = xcd_barrier_post((unsigned*)(F.ctlf) + CW_BAR, MISC + 8);
    if (threadIdx.x == 0) MISC[0] = xb_add((unsigned*)(F.ctlf) + CW_XRANK + 64 * (xb_xcc_id() & 15u), 1u);
    F.xrank = 0; F.xidx = 0; F.xn = 1; F.xloc = 1;
#ifndef PH_MASK
#define PH_MASK 0x7fff
#endif
#define IN(k) (((PH_MASK >> (k)) & 1) && lo <= (k) && (k) < hi)
#define SEAM(k) do { if (IN(k) && IN((k) + 1)) xcd_barrier(bar); } while (0)
    LAS unsigned char* ring = F.lds;
    const int cid = (int)blockIdx.x;

    if (IN(0)) { p0_prologue(F); } SEAM(0);
    if (IN(1)) { p0_mod_reduce(F); p0_convert(F); } SEAM(1);
    if (IN(2)) { p1_rows(F); } SEAM(2);
    if (IN(3)) {
        { pg8::Gemm g{WSP(bf16_t, WS_H), WSP(bf16_t, WS_W_IN), DM, DM, DM, 0}; pg8::StaticOrder S; S.init(NT, 14 * 256, F.G, cid);
          epi::EpiProj E{WSP(bf16_t, WS_QLAT), WSP(bf16_t, WS_KVLAT), WSP(bf16_t, WS_KR), WSP(bf16_t, WS_MQ), WSP(bf16_t, WS_MK), CTL_FX(CW_SSQ), CTL_FX(CW_SSKV), WSP(f32x2, WS_ROPE)};
          pg8::gemm_phase(ring, g, S, E); }
        { pg8::Gemm g{WSP(bf16_t, WS_W_IN) + (size_t)3584 * DM, WSP(bf16_t, WS_H), DM, DM, DM, 0}; pg8::StaticOrder S; S.init(1024, NT, F.G, cid);
          epi::EpiVT E{WSP(bf16_t, WS_MVT), nullptr, 0.f};
          pg8::gemm_phase(ring, g, S, E); }
    } SEAM(3);
    if (IN(4)) {
        { pg8::Gemm g{WSP(bf16_t, WS_QLAT), WSP(bf16_t, WS_W_UQ), QR, QR, QR, 0}; pg8::StaticOrder S; S.init(NT, NH * QKD, F.G, cid);
          epi::EpiQ E{WSP(bf16_t, WS_QM), CTL_FX(CW_SSQ), WSP(f32x2, WS_ROPE)};
          pg8::gemm_phase(ring, g, S, E); }
        { pg8::Gemm g{WSP(bf16_t, WS_KVLAT), WSP(bf16_t, WS_W_UKV), KVR, KVR, KVR, 0}; pg8::StaticOrder S; S.init(NT, 1024, F.G, cid);
          epi::EpiRow E{WSP(bf16_t, WS_KM), 1024, CTL_FX(CW_SSKV), 1.0f / KVR};
          pg8::gemm_phase(ring, g, S, E); }
        { pg8::Gemm g{WSP(bf16_t, WS_W_UKV) + (size_t)1024 * KVR, WSP(bf16_t, WS_KVLAT), KVR, KVR, KVR, 0}; pg8::StaticOrder S; S.init(1024, NT, F.G, cid);
          epi::EpiVT E{WSP(bf16_t, WS_VMT), CTL_FX(CW_SSKV), 1.0f / KVR};
          pg8::gemm_phase(ring, g, S, E); }
        p3_kmean(F);
    } SEAM(4);
    if (IN(5)) {
        attn::Args A{WSP(bf16_t, WS_QM), WSP(bf16_t, WS_KM), WSP(bf16_t, WS_KR), WSP(bf16_t, WS_VMT), WSP(bf16_t, WS_MQ), WSP(bf16_t, WS_MK), WSP(bf16_t, WS_MVT), WSP(bf16_t, WS_KMEAN), WSP(float, WS_KMAX), WSP(unsigned, WS_SELM), WSP(unsigned short, WS_LIST), WSP(int, WS_CNT), WSP(float, WS_QN), WSP(bf16_t, WS_PO), WSP(f32x2, WS_PML),
                     WSP(bf16_t, WS_O), CTL_FX(CW_SSA), CTL_FX(CW_SSB)};
        { PHASE_TID(); attn::moba_gate_phase(A, F.vcu * NWAVES + wave, F.G * NWAVES); }
        xcd_barrier(bar);
        { PHASE_TID(); attn::moba_list_phase(A, F.vcu * NWAVES + wave, F.G * NWAVES); }
        xcd_barrier(bar);
        attn::mla_phase(ring, A, F.vcu, F.G);
        __syncthreads();
        attn::moba_routed_phase(ring, A, F.vcu, F.G);
        xcd_barrier(bar);
        attn::moba_own_phase(ring, A, F.vcu, F.G);
    } SEAM(5);
    if (IN(6)) {
        pg8::Gemm g{WSP(bf16_t, WS_O), WSP(bf16_t, WS_W_OUT), DM, DM, DM, 0}; pg8::StaticOrder S; S.init(NT, DM, F.G, cid);
        epi::EpiOut E{WSP(bf16_t, WS_Y), CTL_FX(CW_SSA), CTL_FX(CW_SSB), CTL_FX(CW_SSY)};
        pg8::gemm_phase(ring, g, S, E);
    } SEAM(6);
    if (IN(7)) { p6_rows(F); } SEAM(7);
    if (IN(8)) {
        pg8::Gemm g{WSP(bf16_t, WS_H), WSP(bf16_t, WS_W_PQ), DM, DM, DM, 0}; pg8::StaticOrder S; S.init(NT, DM, F.G, cid);
        epi::EpiQPF E{WSP(bf16_t, WS_QP)};
        pg8::gemm_phase(ring, g, S, E);
    } SEAM(8);
    if (IN(10)) { p9_scores_topk(F); } SEAM(10);
    if (IN(11) || IN(13)) {
        if (threadIdx.x == 0) { unsigned* bw = (unsigned*)(F.ctlf) + CW_BAR; unsigned idx = 0u, nx = 0u, mine = 1u;
            for (unsigned j = 0; j < 16; ++j) { const unsigned c = xb_ld(&bw[XB_XCNT(j)]); if (c > 0u) { if (j < bar.x) ++idx; ++nx; } if (j == bar.x) mine = c > 0u ? c : 1u; }
            MISC[1] = idx; MISC[2] = nx > 0u ? nx : 1u; MISC[3] = mine; }
        __syncthreads();
        F.xrank = (int)MISC[0]; F.xidx = (int)MISC[1]; F.xn = (int)MISC[2]; F.xloc = (int)MISC[3];
        if (F.xrank >= F.xloc) F.xrank = F.xrank % F.xloc;
    }
    if (IN(11)) { p11_pdots(F); } SEAM(11);
    if (IN(12)) { p11_coef(F); } SEAM(12);
    if (IN(13)) { p12_axpy(F); } SEAM(13);
    if (IN(14)) { p13_rows(F); }
#undef IN
#undef SEAM
}

extern "C" void kernel_launch(void* const* d_in, const int* in_sizes, int n_in, void* d_out, int out_size, void* d_ws, size_t ws_size, hipStream_t stream) {
    static int grid = 0;
    if (grid == 0) {
        if (n_in != 21 || out_size != NT * DM || ws_size < WS_END) { fprintf(stderr, "kernel_launch: unexpected shapes (n_in %d, out %d, ws %zu)\n", n_in, out_size, ws_size); grid = -1; return; }
        int dev = 0, cus = 0, per_cu = 0;
        if (hipGetDevice(&dev) != hipSuccess || hipDeviceGetAttribute(&cus, hipDeviceAttributeMultiprocessorCount, dev) != hipSuccess) { grid = -1; return; }
        if (hipFuncSetAttribute((const void*)hymba_fwd, hipFuncAttributeMaxDynamicSharedMemorySize, LDS_BYTES) != hipSuccess) { fprintf(stderr, "kernel_launch: hipFuncSetAttribute failed\n"); grid = -1; return; }
        if (hipOccupancyMaxActiveBlocksPerMultiprocessor(&per_cu, (const void*)hymba_fwd, NWAVES * 64, LDS_BYTES) != hipSuccess || per_cu < 1)
            fprintf(stderr, "kernel_launch: occupancy query reports %d workgroups per CU\n", per_cu);
        (void)hipGetLastError();
        grid = cus;
    }
    if (grid < 0) return;
    (void)hipMemsetAsync((char*)d_ws + WS_CTL, 0, CTL_ZERO_BYTES, stream);
    Args a{};
    for (int i = 0; i < 21; ++i) a.in[i] = (const float*)d_in[i];
    a.out = (float*)d_out; a.ws = (unsigned char*)d_ws;
#if MK_N_LAUNCHES == 1
    a.ph_lo = 0; a.ph_hi = N_PHASES;
    hipLaunchKernelGGL(hymba_fwd, dim3(grid), dim3(NWAVES * 64), LDS_BYTES, stream, a);
#else
    for (int p = 0; p < N_PHASES; ++p) { a.ph_lo = p; a.ph_hi = p + 1; hipLaunchKernelGGL(hymba_fwd, dim3(grid), dim3(NWAVES * 64), LDS_BYTES, stream, a); }
#endif
}
```
